# Optimizing an MI355X kernel written in HIP

```python
import math
import jax, jax.numpy as jnp
from jax import lax
import numpy as np

D_MODEL = 1024
BATCH = 16
SEQ = 256
DEPTH = 1
DEC_BATCH = 4
DEC_SEQ = 2048
PAST_LEN = 256

GRID_W = 64
N_HEADS_A = 8
DK_A = 64
DV_A = 2 * DK_A
E_A = N_HEADS_A * DV_A
N_HEADS_R = 8
DK_R = 64
DV_R = 2 * DK_R
E_R = N_HEADS_R * DV_R
CHUNK = 128
Q_BLOCK = 128
ROPE_BASE = 10000.0
QA_W = N_HEADS_A * 2 * DK_A
KA_W = N_HEADS_A * 2 * DK_A
VA_W = E_A
ZA_W = E_A
QR_W = N_HEADS_R * DK_R
KR_W = N_HEADS_R * DK_R
VR_W = E_R
ZR_W = E_R
IN_W = QA_W + KA_W + VA_W + ZA_W + QR_W + KR_W + VR_W + ZR_W
IN_SPLITS = (QA_W, QA_W + KA_W, QA_W + KA_W + VA_W, QA_W + KA_W + VA_W + ZA_W,
             QA_W + KA_W + VA_W + ZA_W + QR_W, QA_W + KA_W + VA_W + ZA_W + QR_W + KR_W,
             QA_W + KA_W + VA_W + ZA_W + QR_W + KR_W + VR_W)
DEEPNORM_ALPHA = (2.0 * DEPTH) ** 0.25
DEEPNORM_BETA = (8.0 * DEPTH) ** -0.25
MOD_EPS = 1e-6
LN_EPS = 1e-5

kernel_name = "diff_retention_adaln_prefix_step"

F32 = jnp.float32


def _layernorm(x, eps):
    xf = x.astype(F32)
    mu = jnp.mean(xf, axis=-1, keepdims=True)
    var = jnp.mean(jnp.square(xf - mu), axis=-1, keepdims=True)
    return (xf - mu) * lax.rsqrt(var + eps)


def _axial_rope(n_tokens):
    rows = n_tokens // GRID_W
    r = jnp.broadcast_to(jnp.arange(rows, dtype=F32)[:, None], (rows, GRID_W)).reshape(-1)
    col = jnp.broadcast_to(jnp.arange(GRID_W, dtype=F32)[None, :], (rows, GRID_W)).reshape(-1)
    n_freq = DK_A // 4
    inv = ROPE_BASE ** (-jnp.arange(n_freq, dtype=F32) / n_freq)
    ang = jnp.concatenate([r[:, None] * inv, col[:, None] * inv], axis=-1)
    return jnp.cos(ang), jnp.sin(ang)


def _apply_rope(x, cos, sin):
    xf = x.astype(F32)
    x1 = xf[..., 0::2]
    x2 = xf[..., 1::2]
    c = cos[None, :, None, None, :]
    s = sin[None, :, None, None, :]
    out = jnp.stack([x1 * c - x2 * s, x1 * s + x2 * c], axis=-1).reshape(x.shape)
    return out.astype(x.dtype)


def _diff_attention(q, k, v, lam):
    b, nq = q.shape[0], q.shape[1]
    nb = nq // Q_BLOCK
    qb = jnp.moveaxis(q.reshape(b, nb, Q_BLOCK, N_HEADS_A, 2, DK_A), 1, 0)
    kf = k.astype(F32)
    vf = v.astype(F32)
    scale = DK_A ** -0.5

    def block(qblk):
        s = jnp.einsum('bqhmd,bkhmd->bmhqk', qblk.astype(F32), kf) * scale
        p = jax.nn.softmax(s, axis=-1)
        w = p[:, 0] - lam * p[:, 1]
        return jnp.einsum('bhqk,bkhd->bqhd', w, vf)

    o = lax.map(block, qb)
    return jnp.moveaxis(o, 0, 1).reshape(b, nq, N_HEADS_A, DV_A)


def _retention_scan(q, k, v, log_gamma, s0):
    b, n, h, dk = q.shape
    dv = v.shape[-1]
    nc = n // CHUNK
    idx = jnp.arange(CHUNK, dtype=F32)
    lg = log_gamma.astype(F32)
    rel = idx[:, None] - idx[None, :]
    decay_in = jnp.where(rel[None] >= 0, jnp.exp(lg[:, None, None] * jnp.maximum(rel, 0.0)[None]), 0.0)
    q_dec = jnp.exp(lg[:, None] * (idx + 1.0))[..., None]
    k_dec = jnp.exp(lg[:, None] * (CHUNK - 1.0 - idx))[..., None]
    chunk_dec = jnp.exp(lg * CHUNK)[:, None, None]

    def to_chunks(a):
        return a.astype(F32).reshape(b, nc, CHUNK, h, a.shape[-1]).transpose(1, 0, 3, 2, 4)

    def step(s, inp):
        qb, kb, vb = inp
        inner = jnp.einsum('bhik,bhjk->bhij', qb, kb) * decay_in
        o = jnp.einsum('bhij,bhjv->bhiv', inner, vb) + jnp.einsum('bhik,bhkv->bhiv', qb, s) * q_dec
        s = s * chunk_dec + jnp.einsum('bhjk,bhjv->bhkv', kb * k_dec, vb)
        return s, o

    s_fin, o = lax.scan(step, s0.astype(F32), (to_chunks(q), to_chunks(k), to_chunks(v)))
    o = o.transpose(1, 0, 3, 2, 4).reshape(b, n, h, dv)
    return o, s_fin


def _mixer_layer(x, cond, p, layer_idx, ctx):
    b, n, _ = x.shape
    mod = jax.nn.silu(cond.astype(F32)) @ p['w_mod'].astype(F32) + p['b_mod'].astype(F32)
    shift, scale, gate = jnp.split(mod[:, None, :], 3, axis=-1)
    h = (_layernorm(x, MOD_EPS) * (1.0 + scale) + shift).astype(x.dtype)

    proj = h @ p['w_in']
    qa, ka, va, za, qr, kr, vr, zr = jnp.split(proj, IN_SPLITS, axis=-1)
    qa = qa.reshape(b, n, N_HEADS_A, 2, DK_A)
    ka = ka.reshape(b, n, N_HEADS_A, 2, DK_A)
    va = va.reshape(b, n, N_HEADS_A, DV_A)
    qr = qr.reshape(b, n, N_HEADS_R, DK_R)
    kr = kr.reshape(b, n, N_HEADS_R, DK_R) * (DK_R ** -0.5)
    vr = vr.reshape(b, n, N_HEADS_R, DV_R)

    if ctx is None:
        k_all, v_all = ka, va
    else:
        cos, sin = _axial_rope(n)
        qa = _apply_rope(qa, cos, sin)
        ka_rot = _apply_rope(ka, cos, sin)
        ctx_k = ctx[0].reshape(b, ctx[0].shape[1], N_HEADS_A, 2, DK_A).astype(ka.dtype)
        k_all = jnp.concatenate([ctx_k, ka_rot], axis=1)
        v_all = jnp.concatenate([ctx[1].astype(va.dtype), va], axis=1)
    lam_init = 0.8 - 0.6 * math.exp(-0.3 * layer_idx)
    lp = p['lam'].astype(F32)
    lam = jnp.exp(jnp.sum(lp[0] * lp[1])) - jnp.exp(jnp.sum(lp[2] * lp[3])) + lam_init
    oa = _diff_attention(qa, k_all, v_all, lam)
    oa = oa * lax.rsqrt(jnp.mean(jnp.square(oa), axis=-1, keepdims=True) + LN_EPS)
    oa = oa * p['subln_g'].astype(F32) * (1.0 - lam_init)
    oa = (oa.reshape(b, n, E_A).astype(x.dtype) * jax.nn.silu(za)) @ p['w_pa']

    log_g = jnp.log1p(-jnp.exp2(p['ret_decay'].astype(F32)))
    if ctx is None:
        s0f = jnp.zeros((b, N_HEADS_R, DK_R, DV_R), F32)
        s0b = s0f
    else:
        s0f, s0b = ctx[2], ctx[3]
    of, sf = _retention_scan(qr, kr, vr, log_g[0], s0f)
    ob, sb = _retention_scan(qr[:, ::-1], kr[:, ::-1], vr[:, ::-1], log_g[1], s0b)
    orr = of + ob[:, ::-1]
    orr = _layernorm(orr, LN_EPS).reshape(b, n, E_R) * p['ret_gn_g'].astype(F32)
    orr = (orr.astype(x.dtype) * jax.nn.silu(zr)) @ p['w_pr']

    g = jax.nn.sigmoid((h @ p['w_gate'] + p['b_gate']).astype(F32))
    ga, gr = jnp.split(g, 2, axis=-1)
    m = (ga * oa.astype(F32) + gr * orr.astype(F32)).astype(x.dtype)
    out = (m @ p['w_out']).astype(F32)
    y = _layernorm(DEEPNORM_ALPHA * x.astype(F32) + gate * out, LN_EPS)
    y = (y * p['ln_g'].astype(F32) + p['ln_b'].astype(F32)).astype(x.dtype)
    if ctx is None:
        ctx_out = (ka.reshape(b, n, N_HEADS_A, 2 * DK_A), va, sf.astype(x.dtype), sb.astype(x.dtype))
        return y, ctx_out
    return y, None


def setup_inputs(seed: int = 0) -> dict:
    key = jax.random.key(seed)
    ks = jax.random.split(key, 24)

    def nrm(k, shape, s):
        return jax.random.normal(k, shape, F32) * s

    return {
        "x_prompt": nrm(ks[0], (BATCH, SEQ, D_MODEL), 1.0),
        "x_sample": nrm(ks[1], (DEC_BATCH, DEC_SEQ, D_MODEL), 1.0),
        "cache_attn_k": nrm(ks[2], (DEC_BATCH, DEPTH, PAST_LEN, N_HEADS_A, 2 * DK_A), 1.0),
        "cache_attn_v": nrm(ks[3], (DEC_BATCH, DEPTH, PAST_LEN, N_HEADS_A, DV_A), 1.0),
        "state_ret_fwd": nrm(ks[4], (DEC_BATCH, DEPTH, N_HEADS_R, DK_R, DV_R), 0.5),
        "state_ret_bwd": nrm(ks[5], (DEC_BATCH, DEPTH, N_HEADS_R, DK_R, DV_R), 0.5),
        "c": nrm(ks[6], (DEC_BATCH, D_MODEL), 1.0),
        "c_ctx": nrm(ks[7], (D_MODEL,), 1.0),
        "w_mod": nrm(ks[8], (DEPTH, D_MODEL, 3 * D_MODEL), 0.5 * D_MODEL ** -0.5),
        "b_mod": nrm(ks[9], (DEPTH, 3 * D_MODEL), 0.02),
        "w_in": nrm(ks[10], (DEPTH, D_MODEL, IN_W), D_MODEL ** -0.5),
        "lam_params": nrm(ks[11], (DEPTH, 4, DK_A), 0.1),
        "subln_g": 1.0 + nrm(ks[12], (DEPTH, DV_A), 0.02),
        "ret_decay": (-5.0 - jnp.arange(N_HEADS_R, dtype=F32))[None, None, :] + nrm(ks[13], (DEPTH, 2, N_HEADS_R), 0.1),
        "ret_gn_g": 1.0 + nrm(ks[14], (DEPTH, E_R), 0.02),
        "w_pa": nrm(ks[15], (DEPTH, E_A, D_MODEL), DEEPNORM_BETA * E_A ** -0.5),
        "w_pr": nrm(ks[16], (DEPTH, E_R, D_MODEL), DEEPNORM_BETA * E_R ** -0.5),
        "w_gate": nrm(ks[17], (DEPTH, D_MODEL, 2 * D_MODEL), D_MODEL ** -0.5),
        "b_gate": nrm(ks[18], (DEPTH, 2 * D_MODEL), 0.02),
        "w_out": nrm(ks[19], (DEPTH, D_MODEL, D_MODEL), DEEPNORM_BETA * D_MODEL ** -0.5),
        "ln_g": 1.0 + nrm(ks[20], (DEPTH, D_MODEL), 0.02),
        "ln_b": nrm(ks[21], (DEPTH, D_MODEL), 0.02),
    }


def reference(x_prompt, x_sample, cache_attn_k, cache_attn_v, state_ret_fwd, state_ret_bwd,
              c, c_ctx, w_mod, b_mod, w_in, lam_params, subln_g, ret_decay, ret_gn_g,
              w_pa, w_pr, w_gate, b_gate, w_out, ln_g, ln_b):
    y_prompt = x_prompt
    y_sample = x_sample
    cond_ctx = jnp.broadcast_to(c_ctx[None, :], (x_prompt.shape[0], D_MODEL))
    k_list, v_list, sf_list, sb_list = [], [], [], []
    for l in range(DEPTH):
        p = {"w_mod": w_mod[l], "b_mod": b_mod[l], "w_in": w_in[l], "lam": lam_params[l],
             "subln_g": subln_g[l], "ret_decay": ret_decay[l], "ret_gn_g": ret_gn_g[l],
             "w_pa": w_pa[l], "w_pr": w_pr[l], "w_gate": w_gate[l], "b_gate": b_gate[l],
             "w_out": w_out[l], "ln_g": ln_g[l], "ln_b": ln_b[l]}
        y_prompt, (k_l, v_l, sf_l, sb_l) = _mixer_layer(y_prompt, cond_ctx, p, l, None)
        k_list.append(k_l)
        v_list.append(v_l)
        sf_list.append(sf_l)
        sb_list.append(sb_l)
        ctx = (cache_attn_k[:, l], cache_attn_v[:, l], state_ret_fwd[:, l], state_ret_bwd[:, l])
        y_sample, _ = _mixer_layer(y_sample, c, p, l, ctx)
    new_attn_k = jnp.stack(k_list, axis=1)
    new_attn_v = jnp.stack(v_list, axis=1)
    new_ret_fwd = jnp.stack(sf_list, axis=1)
    new_ret_bwd = jnp.stack(sb_list, axis=1)
    return (y_prompt, y_sample, new_attn_k, new_attn_v, new_ret_fwd, new_ret_bwd)
```

```cpp
#include <hip/hip_runtime.h>
#include <cstdio>
#include <cstdint>

#define GAS __attribute__((address_space(1)))
#define LAS __attribute__((address_space(3)))
typedef unsigned short bf16_t;
typedef short bf16x8 __attribute__((ext_vector_type(8)));
typedef short s16x4 __attribute__((ext_vector_type(4)));
typedef float f32x2 __attribute__((ext_vector_type(2)));
typedef float f32x4 __attribute__((ext_vector_type(4)));
typedef float f32x8 __attribute__((ext_vector_type(8)));
typedef float f32x16 __attribute__((ext_vector_type(16)));
typedef unsigned u32x2 __attribute__((ext_vector_type(2)));
typedef unsigned u32x4 __attribute__((ext_vector_type(4)));

constexpr int DM = 1024;
constexpr int M_CTX = 4096, M_LAT = 8192, MTOK = M_CTX + M_LAT;
constexpr int N_IN = 7168, N_GATE = 2048, N_CAT = N_IN + N_GATE;
constexpr int NH = 8;
constexpr int CTX_B = 16, CTX_N = 256, LAT_B = 4, LAT_N = 2048, PAST = 256, LAT_KEYS = PAST + LAT_N;
constexpr int NCHUNK = MTOK / 128;
constexpr float LN_EPS = 1e-5f, MOD_EPS = 1e-6f;
constexpr float DN_ALPHA = 1.189207115002721f;
constexpr float LAM_INIT = 0.2f;

__device__ __forceinline__ unsigned cvt_pk_bf16(float lo, float hi) { unsigned r; asm volatile("v_cvt_pk_bf16_f32 %0, %1, %2" : "=v"(r) : "v"(lo), "v"(hi)); return r; }
__device__ __forceinline__ float bf_lo(unsigned w) { return __uint_as_float(w << 16); }
__device__ __forceinline__ float bf_hi(unsigned w) { return __uint_as_float(w & 0xffff0000u); }
__device__ __forceinline__ float bf2f(bf16_t h) { return __uint_as_float((unsigned)h << 16); }
__device__ __forceinline__ float fast_rcp(float x) { return __builtin_amdgcn_rcpf(x); }
__device__ __forceinline__ float silu_f(float v) { return v * fast_rcp(1.f + __builtin_amdgcn_exp2f(-1.4426950408889634f * v)); }
__device__ __forceinline__ float sigmoid_f(float v) { return fast_rcp(1.f + __builtin_amdgcn_exp2f(-1.4426950408889634f * v)); }

namespace pg8 {
#define PG8_LAS __attribute__((address_space(3)))
constexpr int BM = 256, BK = 64, HALF = 128, HTB = HALF * BK * 2  , STAGE_BYTES = 8 * HTB, NXCD = 8, WGM = 8;

__host__ __device__ __forceinline__ int lds_byte(int r, int c) { const int st = (r >> 4) * 2 + (c >> 5), rr = r & 15, cc = c & 31, ob = rr * 64 + cc * 2; return st * 1024 + (ob ^ (((ob >> 9) & 1) << 5)); }
__host__ __device__ __forceinline__ void stage_rc(int b, int& R, int& C) { const int st = b / 1024, sb = b % 1024, swz = sb ^ (((sb >> 9) & 1) << 5); R = (st >> 1) * 16 + swz / 64; C = (st & 1) * 32 + (swz % 64) / 2; }
__host__ __device__ __forceinline__ int perm32(int rho) { const int n = rho >> 4, i = rho & 15; return 8 * (i >> 2) + 4 * n + (i & 3); }

struct Unit { int pm, pn, sel; };
struct Gemm { const bf16_t* A; const bf16_t* Bt; const bf16_t* A2; const bf16_t* Bt2; int M, N, K; };

struct StaticOrder {
    int nM, nN, nwg, G, c, rep;
    __host__ __device__ void init(int M, int N, int G_, int c_, int rep_ = 1) { nM = M / BM; nN = N / BM; nwg = nM * nN; G = G_; c = c_; rep = rep_; }
    __host__ __device__ bool next(int i, Unit& u) const {
        long L = (long)i * G + c; if (L >= (long)nwg * rep) return false;
        L %= nwg;
        int wgid = (int)L; { const int q = nwg / NXCD, r = nwg % NXCD, xcd = wgid % NXCD, off = wgid / NXCD; wgid = (xcd < r ? xcd * (q + 1) : r * (q + 1) + (xcd - r) * q) + off; }
        const int nig = WGM * nN, gid = wgid / nig, fm = gid * WGM, gsz = (nM - fm) < WGM ? (nM - fm) : WGM;
        u.pm = fm + ((wgid % nig) % gsz); u.pn = (wgid % nig) / gsz; u.sel = 0; return true;
    }
    __device__ __forceinline__ void a_ready(const Unit&) const {}
    __device__ __forceinline__ void done(const Unit&) const {}
};
template <bool PAIR> struct PanelOrder {
    int c, rep;
    __device__ __forceinline__ bool next(int i, Unit& u) const {
        const int xcd = c & 7, idx = c >> 3;
        if (idx >= 24 || i >= (PAIR ? 2 : 1) * rep) return false;
        u.pm = xcd * 6 + (idx >> 2); u.pn = idx & 3; u.sel = PAIR ? (i & 1) : 0; return true;
    }
    __device__ __forceinline__ void a_ready(const Unit&) const {}
    __device__ __forceinline__ void done(const Unit&) const {}
};


struct EpiProj {
    static constexpr bool PERM = true, AFTER_DRAIN = false;
    __device__ static __forceinline__ bool keep_acc(const Unit&) { return false; }
    bf16_t *QA, *ZA, *QR, *KR, *VR, *ZR, *G, *KC, *VC, *KL, *VL;
    float *outK, *outV; const float* rope; const float* b_gate;
    __device__ __forceinline__ static void st8(bf16_t* p, const f32x4& a, const f32x4& b) {
        u32x4 w; w.x = cvt_pk_bf16(a[0], a[1]); w.y = cvt_pk_bf16(a[2], a[3]); w.z = cvt_pk_bf16(b[0], b[1]); w.w = cvt_pk_bf16(b[2], b[3]); *(u32x4*)p = w; }
    __device__ __forceinline__ void rope8(f32x4& a, f32x4& b, int pos, int dcol) const {
        const int i0 = dcol >> 1, p = (i0 < 16) ? (pos >> 6) : (pos & 63), f0 = i0 & 15;
        const f32x4 t0 = *(const f32x4*)(rope + (p * 16 + f0) * 2), t1 = *(const f32x4*)(rope + (p * 16 + f0) * 2 + 4);
        f32x4 ra, rb;
        ra[0] = a[0] * t0[0] - a[1] * t0[1]; ra[1] = a[0] * t0[1] + a[1] * t0[0]; ra[2] = a[2] * t0[2] - a[3] * t0[3]; ra[3] = a[2] * t0[3] + a[3] * t0[2];
        rb[0] = b[0] * t1[0] - b[1] * t1[1]; rb[1] = b[0] * t1[1] + b[1] * t1[0]; rb[2] = b[2] * t1[2] - b[3] * t1[3]; rb[3] = b[2] * t1[3] + b[3] * t1[2];
        a = ra; b = rb;
    }
    __device__ __forceinline__ void operator()(f32x4 (&acc)[2][2][4][2], const Unit& u, int wr, int wc, int fr, int fq) const {
        const int pn = u.pn; const bool ctx = u.pm < (M_CTX / BM);
        const int row0 = u.pm * BM + wr * 64 + fr;
        int seg, cs0;
        if (pn < 4) { seg = 0; cs0 = pn * 256; } else if (pn < 8) { seg = 1; cs0 = (pn - 4) * 256; } else if (pn < 12) { seg = 2; cs0 = (pn - 8) * 256; }
        else if (pn < 16) { seg = 3; cs0 = (pn - 12) * 256; } else if (pn < 18) { seg = 4; cs0 = (pn - 16) * 256; } else if (pn < 20) { seg = 5; cs0 = (pn - 18) * 256; }
        else if (pn < 24) { seg = 6; cs0 = (pn - 20) * 256; } else if (pn < 28) { seg = 7; cs0 = (pn - 24) * 256; } else { seg = 8; cs0 = (pn - 28) * 256; }
        const int colw = cs0 + wc * 32 + 8 * fq;
#pragma unroll
        for (int ai = 0; ai < 2; ++ai)
#pragma unroll
            for (int m = 0; m < 4; ++m) {
                const int row = row0 + ai * HALF + m * 16;
                const int lrow = row - M_CTX, lb = lrow >> 11, pos = lrow & (LAT_N - 1);
#pragma unroll
                for (int bj = 0; bj < 2; ++bj) {
                    const int col = colw + bj * HALF;
                    f32x4 v0 = acc[ai][bj][m][0], v1 = acc[ai][bj][m][1];
                    if (seg == 0) {
                        if (!ctx) rope8(v0, v1, pos, col & 63);
                        st8(QA + (size_t)row * 1024 + col, v0, v1);
                    } else if (seg == 1) {
                        if (ctx) { float* o = outK + (size_t)row * 1024 + col; *(f32x4*)o = v0; *(f32x4*)(o + 4) = v1; st8(KC + (size_t)row * 1024 + col, v0, v1); }
                        else { rope8(v0, v1, pos, col & 63); st8(KL + ((size_t)lb * LAT_KEYS + PAST + pos) * 1024 + col, v0, v1); }
                    } else if (seg == 2) {
                        if (ctx) { float* o = outV + (size_t)row * 1024 + col; *(f32x4*)o = v0; *(f32x4*)(o + 4) = v1; st8(VC + (size_t)row * 1024 + col, v0, v1); }
                        else st8(VL + ((size_t)lb * LAT_KEYS + PAST + pos) * 1024 + col, v0, v1);
                    } else if (seg == 3 || seg == 7) {
#pragma unroll
                        for (int k = 0; k < 4; ++k) { v0[k] = silu_f(v0[k]); v1[k] = silu_f(v1[k]); }
                        st8((seg == 3 ? ZA : ZR) + (size_t)row * 1024 + col, v0, v1);
                    } else if (seg == 4) {
                        st8(QR + (size_t)row * 512 + col, v0, v1);
                    } else if (seg == 5) {
                        v0 = v0 * 0.125f; v1 = v1 * 0.125f; st8(KR + (size_t)row * 512 + col, v0, v1);
                    } else if (seg == 6) {
                        st8(VR + (size_t)row * 1024 + col, v0, v1);
                    } else {
                        const f32x4 b0 = *(const f32x4*)(b_gate + col), b1 = *(const f32x4*)(b_gate + col + 4);
#pragma unroll
                        for (int k = 0; k < 4; ++k) { v0[k] = sigmoid_f(v0[k] + b0[k]); v1[k] = sigmoid_f(v1[k] + b1[k]); }
                        st8(G + (size_t)row * 2048 + col, v0, v1);
                    }
                }
            }
    }
};

struct EpiMerge {
    static constexpr bool PERM = true, AFTER_DRAIN = false;
    __device__ static __forceinline__ bool keep_acc(const Unit& u) { return u.sel == 0; }
    const bf16_t* G; bf16_t* Mo;
    __device__ __forceinline__ void operator()(f32x4 (&acc)[2][2][4][2], const Unit& u, int wr, int wc, int fr, int fq) const {
        const int row0 = u.pm * BM + wr * 64 + fr, col0 = u.pn * BM + wc * 32 + 8 * fq;
#pragma unroll
        for (int ai = 0; ai < 2; ++ai)
#pragma unroll
            for (int m = 0; m < 4; ++m) {
                const int row = row0 + ai * HALF + m * 16;
#pragma unroll
                for (int bj = 0; bj < 2; ++bj) {
                    const int col = col0 + bj * HALF;
                    const u32x4 gr = *(const u32x4*)(G + (size_t)row * 2048 + 1024 + col);
                    if (u.sel == 0) {
                        const u32x4 ga = *(const u32x4*)(G + (size_t)row * 2048 + col);
                        f32x4 r0, r1;
                        r0[0] = bf_lo(ga.x) * fast_rcp(bf_lo(gr.x)); r0[1] = bf_hi(ga.x) * fast_rcp(bf_hi(gr.x)); r0[2] = bf_lo(ga.y) * fast_rcp(bf_lo(gr.y)); r0[3] = bf_hi(ga.y) * fast_rcp(bf_hi(gr.y));
                        r1[0] = bf_lo(ga.z) * fast_rcp(bf_lo(gr.z)); r1[1] = bf_hi(ga.z) * fast_rcp(bf_hi(gr.z)); r1[2] = bf_lo(ga.w) * fast_rcp(bf_lo(gr.w)); r1[3] = bf_hi(ga.w) * fast_rcp(bf_hi(gr.w));
                        acc[ai][bj][m][0] = acc[ai][bj][m][0] * r0; acc[ai][bj][m][1] = acc[ai][bj][m][1] * r1;
                    } else {
                        f32x4 g0, g1;
                        g0[0] = bf_lo(gr.x); g0[1] = bf_hi(gr.x); g0[2] = bf_lo(gr.y); g0[3] = bf_hi(gr.y); g1[0] = bf_lo(gr.z); g1[1] = bf_hi(gr.z); g1[2] = bf_lo(gr.w); g1[3] = bf_hi(gr.w);
                        const f32x4 v0 = acc[ai][bj][m][0] * g0, v1 = acc[ai][bj][m][1] * g1;
                        u32x4 w; w.x = cvt_pk_bf16(v0[0], v0[1]); w.y = cvt_pk_bf16(v0[2], v0[3]); w.z = cvt_pk_bf16(v1[0], v1[1]); w.w = cvt_pk_bf16(v1[2], v1[3]);
                        *(u32x4*)(Mo + (size_t)row * 1024 + col) = w;
                    }
                }
            }
    }
};

struct EpiOut {
    static constexpr bool PERM = false, AFTER_DRAIN = true;
    __device__ static __forceinline__ bool keep_acc(const Unit&) { return false; }
    const float* xc; const float* xl; const float* modf; float* out; float* stats;
    __device__ __forceinline__ void operator()(f32x4 (&)[2][2][4][2], const Unit&, int, int, int, int) const {}
    __device__ __forceinline__ void fused(f32x4 (&acc)[2][2][4][2], const Unit& u, int wr, int wc, int fr, int fq, PG8_LAS unsigned char* lds, int wid, int lane) const {
        PG8_LAS f32x2* P = (PG8_LAS f32x2*)lds;
        const bool ctx = u.pm < (M_CTX / BM);
        const int mb = ctx ? 0 : 1 + ((u.pm * BM - M_CTX) >> 11);
        const float* xb = ctx ? xc + (size_t)(u.pm * BM) * DM : xl + (size_t)(u.pm * BM - M_CTX) * DM;
        const int col0 = u.pn * BM + wc * 32 + 4 * fq;
        f32x4 gv[2][2];
#pragma unroll
        for (int bj = 0; bj < 2; ++bj)
#pragma unroll
            for (int n = 0; n < 2; ++n) gv[bj][n] = *(const f32x4*)(modf + mb * 3072 + 2048 + col0 + bj * HALF + n * 16);
#pragma unroll
        for (int ai = 0; ai < 2; ++ai)
#pragma unroll
            for (int m = 0; m < 4; ++m) {
                const int rl = ai * HALF + wr * 64 + m * 16 + fr;
                float s = 0.f;
#pragma unroll
                for (int bj = 0; bj < 2; ++bj)
#pragma unroll
                    for (int n = 0; n < 2; ++n) {
                        const f32x4 xv = *(const f32x4*)(xb + (size_t)rl * DM + col0 + bj * HALF + n * 16);
                        const f32x4 v = xv * DN_ALPHA + gv[bj][n] * acc[ai][bj][m][n];
                        acc[ai][bj][m][n] = v; s += (v[0] + v[1]) + (v[2] + v[3]);
                        *(f32x4*)(out + (size_t)(u.pm * BM + rl) * DM + col0 + bj * HALF + n * 16) = v;
                    }
                s += __shfl_xor(s, 16); s += __shfl_xor(s, 32);
                const float mw = s * (1.0f / 64.0f); float q = 0.f;
#pragma unroll
                for (int bj = 0; bj < 2; ++bj)
#pragma unroll
                    for (int n = 0; n < 2; ++n) { const f32x4 d = acc[ai][bj][m][n] - mw; q += (d[0] * d[0] + d[1] * d[1]) + (d[2] * d[2] + d[3] * d[3]); }
                q += __shfl_xor(q, 16); q += __shfl_xor(q, 32);
                if (fq == 0) P[rl * 4 + wc] = (f32x2){mw, q};
            }
        asm volatile("s_waitcnt lgkmcnt(0)" ::: "memory"); __builtin_amdgcn_s_barrier(); asm volatile("" ::: "memory");
        const int row = wid * 32 + (lane & 31);
        if (lane < 32) {
            const f32x2 a = P[row * 4 + 0], b = P[row * 4 + 1], c = P[row * 4 + 2], d = P[row * 4 + 3];
            const float mt = (a.x + b.x + c.x + d.x) * 0.25f;
            const float da = a.x - mt, db = b.x - mt, dc = c.x - mt, dd = d.x - mt;
            const float m2 = (a.y + b.y) + (c.y + d.y) + 64.0f * ((da * da + db * db) + (dc * dc + dd * dd));
            *(f32x2*)(stats + ((size_t)(u.pm * BM + row) * 4 + u.pn) * 2) = (f32x2){mt, m2};
        }
    }
};

template <class Epi, class Sched, bool ALIGN_EPI = false, bool SP2 = false>
__device__ __forceinline__ void gemm_phase(PG8_LAS unsigned char* lds, const Gemm g, const Sched& S, const Epi& E) {
    const int tid = threadIdx.x, wid = __builtin_amdgcn_readfirstlane(tid >> 6), lane = tid & 63, wr = wid >> 2, wc = wid & 3, fr = lane & 15, fq = lane >> 4;
    const int K = g.K, nt = K / BK;
    unsigned voffA[2], voffB[2];
#pragma unroll
    for (int i = 0; i < 2; ++i) { int R, C; stage_rc(tid * 16 + i * 8192, R, C); const int Rb = Epi::PERM ? ((R & ~31) + perm32(R & 31)) : R;
        voffA[i] = (unsigned)(R * K + C) * 2u; voffB[i] = (unsigned)(Rb * K + C) * 2u; }
    const size_t kstep = (size_t)(BK * 2);
    const size_t hstep = (size_t)HALF * K * 2;
    const size_t tstep = 2 * hstep;
    const unsigned ldsw = (unsigned)wid * 1024u;
    const int aoff = lds_byte(wr * 64 + fr, fq * 8), boff = lds_byte(wc * 32 + fr, fq * 8);
#define PG8_SA(b, h) (((b) * 2 + (h)) * HTB)
#define PG8_SB(b, h) ((4 + (b) * 2 + (h)) * HTB)
#define PG8_STAGE(bufoff, gbase, voff) do { _Pragma("unroll") for (int _i = 0; _i < 2; ++_i) \
        __builtin_amdgcn_global_load_lds((const unsigned*)((const char*)(gbase) + (voff)[_i]), (PG8_LAS unsigned*)(lds + (bufoff) + ldsw + _i * 8192), 16, 0, 0); } while (0)
#define PG8_LDA(dst, b, h) do { _Pragma("unroll") for (int m = 0; m < 4; ++m) _Pragma("unroll") for (int k = 0; k < 2; ++k) dst[m][k] = *(const PG8_LAS bf16x8*)(lds + PG8_SA(b, h) + aoff + m * 2048 + k * 1024); } while (0)
#define PG8_LDB(dst, b, h) do { _Pragma("unroll") for (int n = 0; n < 2; ++n) _Pragma("unroll") for (int k = 0; k < 2; ++k) dst[n][k] = *(const PG8_LAS bf16x8*)(lds + PG8_SB(b, h) + boff + n * 2048 + k * 1024); } while (0)
#define PG8_MMA(ai, bj, At, Bt) do { __builtin_amdgcn_s_setprio(1); _Pragma("unroll") for (int m = 0; m < 4; ++m) _Pragma("unroll") for (int n = 0; n < 2; ++n) _Pragma("unroll") for (int k = 0; k < 2; ++k) \
        acc[ai][bj][m][n] = __builtin_amdgcn_mfma_f32_16x16x32_bf16(Bt[n][k], At[m][k], acc[ai][bj][m][n], 0, 0, 0); __builtin_amdgcn_s_setprio(0); } while (0)
#define PG8_WAIT_V(n) asm volatile("s_waitcnt vmcnt(" #n ")" ::: "memory")
#define PG8_WAIT_L(n) asm volatile("s_waitcnt lgkmcnt(" #n ")" ::: "memory")
#define PG8_BAR __builtin_amdgcn_s_barrier()
#define PG8_SCHED __builtin_amdgcn_sched_barrier(0)
    Unit cur, nxt; int ui = 0;
    if (!S.next(0, cur)) return;
    f32x4 acc[2][2][4][2];
#pragma unroll
    for (int a = 0; a < 2; ++a)
#pragma unroll
        for (int b = 0; b < 2; ++b)
#pragma unroll
            for (int m = 0; m < 4; ++m)
#pragma unroll
                for (int n = 0; n < 2; ++n) acc[a][b][m][n] = (f32x4){0.f, 0.f, 0.f, 0.f};
    bf16x8 At[4][2], B0[2][2], B1[2][2];
    const char* cA = (const char*)(cur.sel ? g.A2 : g.A) + (size_t)cur.pm * tstep; const char* cB = (const char*)(cur.sel ? g.Bt2 : g.Bt) + (size_t)cur.pn * tstep;
    S.a_ready(cur);
    if constexpr (SP2) {
        PG8_STAGE(PG8_SB(0, 0), cB, voffB); PG8_STAGE(PG8_SB(0, 1), cB + hstep, voffB); PG8_STAGE(PG8_SA(0, 0), cA, voffA); PG8_STAGE(PG8_SA(0, 1), cA + hstep, voffA);
        if (wr == 1) PG8_BAR;
        PG8_WAIT_V(2); PG8_BAR;
        PG8_STAGE(PG8_SB(1, 0), cB + kstep, voffB); PG8_STAGE(PG8_SA(1, 0), cA + kstep, voffA); PG8_STAGE(PG8_SB(1, 1), cB + hstep + kstep, voffB);
        PG8_WAIT_V(6); PG8_BAR;
    } else {
        PG8_STAGE(PG8_SB(0, 0), cB, voffB); PG8_STAGE(PG8_SA(0, 0), cA, voffA); PG8_STAGE(PG8_SB(0, 1), cB + hstep, voffB); PG8_STAGE(PG8_SA(0, 1), cA + hstep, voffA);
        if (wr == 1) PG8_BAR;
        PG8_WAIT_V(4); PG8_BAR;
        PG8_STAGE(PG8_SB(1, 0), cB + kstep, voffB); PG8_STAGE(PG8_SA(1, 0), cA + kstep, voffA); PG8_STAGE(PG8_SB(1, 1), cB + hstep + kstep, voffB);
        PG8_WAIT_V(6); PG8_BAR;
    }
    for (;;) {
        const bool has_next = S.next(ui + 1, nxt);
        const char* nA = has_next ? (const char*)(nxt.sel ? g.A2 : g.A) + (size_t)nxt.pm * tstep : cA; const char* nB = has_next ? (const char*)(nxt.sel ? g.Bt2 : g.Bt) + (size_t)nxt.pn * tstep : cB;
        for (int t = 0; t < nt; t += 2) {
            const bool last = (t == nt - 2);
            const char* a1 = cA + (size_t)(t + 1) * kstep;
            const char* a2 = last ? nA : cA + (size_t)(t + 2) * kstep; const char* b2 = last ? nB : cB + (size_t)(t + 2) * kstep;
            const char* a3 = a2 + kstep; const char* b3 = b2 + kstep;
            if (last && has_next) S.a_ready(nxt);
            if constexpr (SP2) {
            PG8_LDB(B0, 0, 0); PG8_LDB(B1, 0, 1); PG8_SCHED; PG8_LDA(At, 0, 0); PG8_STAGE(PG8_SA(1, 1), a1 + hstep, voffA);
            PG8_WAIT_V(8); PG8_WAIT_L(0); PG8_BAR; PG8_MMA(0, 0, At, B0); PG8_MMA(0, 1, At, B1); PG8_BAR; PG8_SCHED;
            PG8_LDA(At, 0, 1); PG8_STAGE(PG8_SB(0, 0), b2, voffB); PG8_STAGE(PG8_SB(0, 1), b2 + hstep, voffB); PG8_STAGE(PG8_SA(0, 0), a2, voffA);
            PG8_WAIT_V(8); PG8_WAIT_L(0); PG8_BAR; PG8_MMA(1, 0, At, B0); PG8_MMA(1, 1, At, B1); PG8_BAR; PG8_SCHED;
            PG8_LDB(B0, 1, 0); PG8_LDB(B1, 1, 1); PG8_SCHED; PG8_LDA(At, 1, 0); PG8_STAGE(PG8_SA(0, 1), a2 + hstep, voffA);
            PG8_WAIT_V(8); PG8_WAIT_L(0); PG8_BAR; PG8_MMA(0, 0, At, B0); PG8_MMA(0, 1, At, B1); PG8_BAR; PG8_SCHED;
            PG8_LDA(At, 1, 1); PG8_STAGE(PG8_SB(1, 0), b3, voffB); PG8_STAGE(PG8_SB(1, 1), b3 + hstep, voffB); PG8_STAGE(PG8_SA(1, 0), a3, voffA);
            PG8_WAIT_V(8); PG8_WAIT_L(0); PG8_BAR; PG8_MMA(1, 0, At, B0); PG8_MMA(1, 1, At, B1); PG8_BAR; PG8_SCHED;
            } else {
            PG8_LDB(B0, 0, 0); PG8_SCHED; PG8_LDA(At, 0, 0); PG8_STAGE(PG8_SA(1, 1), a1 + hstep, voffA);
            PG8_WAIT_L(8); PG8_BAR; PG8_WAIT_L(0); PG8_MMA(0, 0, At, B0); PG8_BAR; PG8_SCHED;
            PG8_LDB(B1, 0, 1); PG8_STAGE(PG8_SB(0, 0), b2, voffB);
            PG8_BAR; PG8_WAIT_L(0); PG8_MMA(0, 1, At, B1); PG8_BAR;
            PG8_LDA(At, 0, 1); PG8_STAGE(PG8_SA(0, 0), a2, voffA);
            PG8_BAR; PG8_WAIT_L(0); PG8_MMA(1, 0, At, B0); PG8_BAR; PG8_SCHED;
            PG8_STAGE(PG8_SB(0, 1), b2 + hstep, voffB);
            PG8_WAIT_V(6); PG8_BAR; PG8_MMA(1, 1, At, B1); PG8_BAR;
            PG8_LDB(B0, 1, 0); PG8_SCHED; PG8_LDA(At, 1, 0); PG8_STAGE(PG8_SA(0, 1), a2 + hstep, voffA);
            PG8_WAIT_L(8); PG8_BAR; PG8_WAIT_L(0); PG8_MMA(0, 0, At, B0); PG8_BAR; PG8_SCHED;
            PG8_LDB(B1, 1, 1); PG8_STAGE(PG8_SB(1, 0), b3, voffB);
            PG8_BAR; PG8_WAIT_L(0); PG8_MMA(0, 1, At, B1); PG8_BAR;
            PG8_LDA(At, 1, 1); PG8_STAGE(PG8_SA(1, 0), a3, voffA);
            PG8_BAR; PG8_WAIT_L(0); PG8_MMA(1, 0, At, B0); PG8_BAR; PG8_SCHED;
            PG8_STAGE(PG8_SB(1, 1), b3 + hstep, voffB);
            PG8_WAIT_V(6); PG8_BAR; PG8_MMA(1, 1, At, B1); PG8_BAR;
            }
        }
        if constexpr (ALIGN_EPI) { if (wr == 0) PG8_BAR; }
        if constexpr (!Epi::AFTER_DRAIN) { E(acc, cur, wr, wc, fr, fq); S.done(cur); }
        if (!has_next) break;
        if (!Epi::keep_acc(cur)) {
#pragma unroll
        for (int a = 0; a < 2; ++a)
#pragma unroll
            for (int b = 0; b < 2; ++b)
#pragma unroll
                for (int m = 0; m < 4; ++m)
#pragma unroll
                    for (int n = 0; n < 2; ++n) acc[a][b][m][n] = (f32x4){0.f, 0.f, 0.f, 0.f};
        }
        cur = nxt; cA = nA; cB = nB; ++ui;
        if constexpr (ALIGN_EPI) { if (wr == 1) PG8_BAR; }
    }
    PG8_WAIT_V(0);
    if constexpr (!ALIGN_EPI) { if (wr == 0) PG8_BAR; }
    PG8_BAR;
    if constexpr (Epi::AFTER_DRAIN) { E.fused(acc, cur, wr, wc, fr, fq, lds, wid, lane); S.done(cur); }
#undef PG8_SA
#undef PG8_SB
#undef PG8_STAGE
#undef PG8_LDA
#undef PG8_LDB
#undef PG8_MMA
#undef PG8_WAIT_V
#undef PG8_WAIT_L
#undef PG8_BAR
#undef PG8_SCHED
}
}

namespace att {
#define SBAR() __builtin_amdgcn_sched_barrier(0)
constexpr int LDK = 1024;
constexpr int KVBLK = 64;
constexpr float SCALE = 0.125f;
constexpr float THR = 8.f;
constexpr int SHM_T = KVBLK * 128 * 2;
constexpr int LDS_V = 0, LDS_K = 2 * SHM_T, LDS_WS = 4 * SHM_T, LDS_OX = 0;
#define KSWZ(row, colB) ((row) * 256 + ((colB) ^ (((row) & 7) << 4)))
#define KSWZ64(row, colB) ((row) * 128 + ((colB) ^ (((row) & 7) << 4)))
__device__ __forceinline__ int crow(int r, int hi) { return (r & 3) + 8 * (r >> 2) + 4 * hi; }

__device__ __forceinline__ void partialSM(f32x16& p0, f32x16& p1, float& m_reg, float& mn, float& alpha) {
  constexpr float C = SCALE * 1.4426950408889634f;
  float pmax = p0[0];
#pragma unroll
  for (int r = 1; r < 16; ++r) pmax = fmaxf(pmax, p0[r]);
#pragma unroll
  for (int r = 0; r < 16; ++r) pmax = fmaxf(pmax, p1[r]);
  { auto rr = __builtin_amdgcn_permlane32_swap(__float_as_uint(pmax), __float_as_uint(pmax), false, false);
    pmax = fmaxf(__uint_as_float(rr[0]), __uint_as_float(rr[1])); }
  if (__builtin_expect(__all(pmax - m_reg <= THR / SCALE), 1)) { mn = m_reg; alpha = 1.f; }
  else { mn = fmaxf(m_reg, pmax); alpha = __builtin_amdgcn_exp2f((m_reg - mn) * C); m_reg = mn; }
  float mnC = -mn * C;
#pragma unroll
  for (int r = 0; r < 16; ++r) p0[r] = fmaf(p0[r], C, mnC);
#pragma unroll
  for (int r = 0; r < 16; ++r) p1[r] = fmaf(p1[r], C, mnC);
#pragma unroll
  for (int r = 0; r < 16; ++r) p0[r] = __builtin_amdgcn_exp2f(p0[r]);
}
#define PK4(P, BASE, OUT) do { unsigned a0 = cvt_pk_bf16(P[BASE + 0], P[BASE + 1]), a1 = cvt_pk_bf16(P[BASE + 2], P[BASE + 3]);   \
    unsigned b0 = cvt_pk_bf16(P[BASE + 4], P[BASE + 5]), b1 = cvt_pk_bf16(P[BASE + 6], P[BASE + 7]);                              \
    auto r0 = __builtin_amdgcn_permlane32_swap(a0, b0, false, false); auto r1 = __builtin_amdgcn_permlane32_swap(a1, b1, false, false); \
    u32x4 w = {r0[0], r1[0], r0[1], r1[1]}; OUT = __builtin_bit_cast(bf16x8, w); } while (0)
__device__ __forceinline__ void packP(const f32x16& p0, const f32x16& p1, bf16x8& pa0, bf16x8& pa1, bf16x8& pa2, bf16x8& pa3) {
  PK4(p0, 0, pa0); PK4(p0, 8, pa1); PK4(p1, 0, pa2); PK4(p1, 8, pa3);
}
__device__ __forceinline__ void finishSM(f32x16& p0, f32x16& p1, float alpha, float& l_reg, bf16x8& pa0, bf16x8& pa1, bf16x8& pa2, bf16x8& pa3) {
#pragma unroll
  for (int r = 0; r < 16; ++r) p1[r] = __builtin_amdgcn_exp2f(p1[r]);
  float ps = 0;
#pragma unroll
  for (int r = 0; r < 16; ++r) ps += p0[r];
#pragma unroll
  for (int r = 0; r < 16; ++r) ps += p1[r];
  { auto rr = __builtin_amdgcn_permlane32_swap(__float_as_uint(ps), __float_as_uint(ps), false, false);
    ps = __uint_as_float(rr[0]) + __uint_as_float(rr[1]); }
  l_reg = l_reg * alpha + ps;
  packP(p0, p1, pa0, pa1, pa2, pa3);
}
__device__ __forceinline__ void qkt(f32x16& p0, f32x16& p1, const char* Ks, const bf16x8* qr, int r32, int hi, int cb0) {
  p0 = f32x16{}; p1 = f32x16{};
#pragma unroll
  for (int d0 = 0; d0 < 4; ++d0) { int cb = cb0 + (d0 * 16 + hi * 8) * 2;
    bf16x8 b0 = *reinterpret_cast<const bf16x8*>(Ks + KSWZ(r32, cb));
    bf16x8 b1 = *reinterpret_cast<const bf16x8*>(Ks + KSWZ(32 + r32, cb));
    p0 = __builtin_amdgcn_mfma_f32_32x32x16_bf16(b0, qr[d0], p0, 0, 0, 0);
    p1 = __builtin_amdgcn_mfma_f32_32x32x16_bf16(b1, qr[d0], p1, 0, 0, 0); }
}
__device__ __forceinline__ int v_st(int k, int c) { const int kk = (k & ~0xC) | ((k & 4) << 1) | ((k & 8) >> 1); return ((kk >> 3) * 4 + (c >> 5)) * 512 + ((kk & 7) * 32 + (c & 31)) * 2; }
__device__ __forceinline__ int v_rd_base(int lane) { return ((lane & 3) << 3) | (((lane >> 2) & 3) << 6) | (((lane >> 4) & 1) << 5) | (((lane >> 5) & 1) << 8); }
template <int OFF> __device__ __forceinline__ s16x4 tr_read(int vb) {
  s16x4 r; asm volatile("ds_read_b64_tr_b16 %0, %1 offset:%2" : "=&v"(r) : "v"(vb), "i"(OFF) : "memory"); return r;
}
#define PKF(L, H) (bf16x8){L[0], L[1], L[2], L[3], H[0], H[1], H[2], H[3]}
__device__ __forceinline__ void pv_blk(f32x16& od, int vb, bf16x8 pa0, bf16x8 pa1, bf16x8 pa2, bf16x8 pa3) {
  const s16x4 l0 = tr_read<0>(vb), h0 = tr_read<2048>(vb), l1 = tr_read<4096>(vb), h1 = tr_read<4096 + 2048>(vb);
  const s16x4 l2 = tr_read<8192>(vb), h2 = tr_read<8192 + 2048>(vb), l3 = tr_read<12288>(vb), h3 = tr_read<12288 + 2048>(vb);
  asm volatile("s_waitcnt lgkmcnt(0)" ::: "memory"); SBAR();
  od = __builtin_amdgcn_mfma_f32_32x32x16_bf16(pa0, PKF(l0, h0), od, 0, 0, 0);
  od = __builtin_amdgcn_mfma_f32_32x32x16_bf16(pa1, PKF(l1, h1), od, 0, 0, 0);
  od = __builtin_amdgcn_mfma_f32_32x32x16_bf16(pa2, PKF(l2, h2), od, 0, 0, 0);
  od = __builtin_amdgcn_mfma_f32_32x32x16_bf16(pa3, PKF(l3, h3), od, 0, 0, 0);
}
__device__ __forceinline__ void pv_d0(f32x16* o, int vb, bf16x8 pa0, bf16x8 pa1, bf16x8 pa2, bf16x8 pa3) {
  pv_blk(o[0], vb, pa0, pa1, pa2, pa3); pv_blk(o[1], vb + 512, pa0, pa1, pa2, pa3); pv_blk(o[2], vb + 1024, pa0, pa1, pa2, pa3); pv_blk(o[3], vb + 1536, pa0, pa1, pa2, pa3);
}
__device__ __forceinline__ void tr_frag4(bf16x8* f, int vb) {
  const s16x4 l0 = tr_read<0>(vb), h0 = tr_read<2048>(vb), l1 = tr_read<4096>(vb), h1 = tr_read<4096 + 2048>(vb);
  const s16x4 l2 = tr_read<8192>(vb), h2 = tr_read<8192 + 2048>(vb), l3 = tr_read<12288>(vb), h3 = tr_read<12288 + 2048>(vb);
  asm volatile("s_waitcnt lgkmcnt(0)" ::: "memory"); SBAR();
  f[0] = PKF(l0, h0); f[1] = PKF(l1, h1); f[2] = PKF(l2, h2); f[3] = PKF(l3, h3);
}

template <int MODE>
__device__ __forceinline__ void combine_store(f32x16 (&o)[4], float lam, const float* gain, const bf16_t* zb, bf16_t* ob, char* lds) {
  int tidx = threadIdx.x; asm volatile("" : "+v"(tidx));
  const int wid = __builtin_amdgcn_readfirstlane(tidx >> 6), half = wid >> 2, w4 = wid & 3, r32 = tidx & 31, hi = (tidx >> 5) & 1;
  float* Ox = (float*)(lds + LDS_OX);
  __syncthreads();
  if (half == 1) {
#pragma unroll
    for (int r = 0; r < 16; ++r) { const int row = w4 * 32 + crow(r, hi);
#pragma unroll
      for (int d0 = 0; d0 < 4; ++d0) Ox[row * 128 + d0 * 32 + r32] = o[d0][r]; }
  }
  __syncthreads();
  if (half == 0) {
    float gn[4];
#pragma unroll
    for (int d0 = 0; d0 < 4; ++d0) gn[d0] = gain[d0 * 32 + r32] * (MODE == 0 ? (1.f - LAM_INIT) : 1.f);
#pragma unroll
    for (int r = 0; r < 16; ++r) { const int row = w4 * 32 + crow(r, hi);
      float s1 = 0.f, s2 = 0.f; float v[4];
#pragma unroll
      for (int d0 = 0; d0 < 4; ++d0) { const float x = Ox[row * 128 + d0 * 32 + r32]; v[d0] = (MODE == 0) ? (o[d0][r] - lam * x) : (o[d0][r] + x); s1 += v[d0]; s2 += v[d0] * v[d0]; }
#pragma unroll
      for (int sh = 1; sh < 32; sh <<= 1) { s1 += __shfl_xor(s1, sh); s2 += __shfl_xor(s2, sh); }
      float mean, rstd;
      if (MODE == 0) { mean = 0.f; rstd = 1.0f / sqrtf(s2 * (1.f / 128.f) + LN_EPS); }
      else { mean = s1 * (1.f / 128.f); float var = s2 * (1.f / 128.f) - mean * mean; var = var < 0.f ? 0.f : var; rstd = 1.0f / sqrtf(var + LN_EPS); }
#pragma unroll
      for (int d0 = 0; d0 < 4; ++d0) { const int col = d0 * 32 + r32; const float z = bf2f(zb[(size_t)row * LDK + col]);
        const float y = (v[d0] - mean) * rstd * gn[d0] * z; ob[(size_t)row * LDK + col] = (bf16_t)(cvt_pk_bf16(y, y) & 0xffffu); }
    }
  }
  __syncthreads();
}

__device__ __forceinline__ void attn_unit(const bf16_t* Qb, const bf16_t* Kh, const bf16_t* Vh, int seq, float lam, const float* subg, const bf16_t* zb, bf16_t* ob, char* lds) {
  const int tid = threadIdx.x, wid = __builtin_amdgcn_readfirstlane(tid >> 6), lane = tid & 63, r32 = lane & 31, hi = lane >> 5, map = wid >> 2, w4 = wid & 3;
  char* V_lds = lds + LDS_V; char* K_lds = lds + LDS_K;
  float* ws = (float*)(lds + LDS_WS) + wid * 64; float* li_l = ws; float* al_l = ws + 32;
  float m_reg = -1e30f, l_reg = 0; f32x16 o[4] = {}; bf16x8 qr[4];
  const bf16_t* Qw = Qb + (size_t)(w4 * 32 + r32) * LDK + map * 64 + hi * 8;
#pragma unroll
  for (int d0 = 0; d0 < 4; ++d0) qr[d0] = *reinterpret_cast<const bf16x8*>(Qw + d0 * 16);
  const int cb0 = map * 128;
  const int sr = tid >> 4, sc = (tid & 15) * 8, vst0 = v_st(sr, sc), vst1 = v_st(32 + sr, sc);
  const int vb0 = (int)(uintptr_t)V_lds + v_rd_base(lane);
  struct { bf16x8 vs0, vs1, ks0, ks1; } sr_[2];
#define SLOAD(i, k0) do { sr_[i].vs0 = *(const bf16x8*)(&Vh[(size_t)((k0) + sr) * LDK + sc]); sr_[i].vs1 = *(const bf16x8*)(&Vh[(size_t)((k0) + 32 + sr) * LDK + sc]); \
    sr_[i].ks0 = *(const bf16x8*)(&Kh[(size_t)((k0) + sr) * LDK + sc]); sr_[i].ks1 = *(const bf16x8*)(&Kh[(size_t)((k0) + 32 + sr) * LDK + sc]); } while (0)
#define SWRITE(b, i) do { *(bf16x8*)(V_lds + (b) * SHM_T + vst0) = sr_[i].vs0;          \
    *(bf16x8*)(V_lds + (b) * SHM_T + vst1) = sr_[i].vs1; int kc = sc * 2;               \
    *(bf16x8*)(K_lds + (b) * SHM_T + KSWZ(sr, kc)) = sr_[i].ks0;                       \
    *(bf16x8*)(K_lds + (b) * SHM_T + KSWZ(32 + sr, kc)) = sr_[i].ks1; } while (0)
#define SWAIT() asm volatile("s_waitcnt vmcnt(4)" ::: "memory")
#define RESC(a) do { if (__any((a) < 1.f)) { if (hi == 0) al_l[r32] = (a); asm volatile("s_waitcnt lgkmcnt(0)" ::: "memory"); \
    _Pragma("unroll") for (int d = 0; d < 4; ++d) _Pragma("unroll") for (int r = 0; r < 16; ++r) o[d][r] *= al_l[crow(r, hi)]; } } while (0)
  f32x16 pA0, pA1, pB0, pB1; float mnA, mnB, alA, alB; bf16x8 pa0, pa1, pa2, pa3; const int NT = seq / KVBLK;
  constexpr int SE = 0, SO = 1;
  SLOAD(SE, 0); asm volatile("s_waitcnt vmcnt(0)" ::: "memory"); SWRITE(0, SE); __syncthreads();
  qkt(pA0, pA1, K_lds, qr, r32, hi, cb0); partialSM(pA0, pA1, m_reg, mnA, alA);
  SLOAD(SO, KVBLK); if (2 < NT) SLOAD(SE, 2 * KVBLK);
  SWAIT(); SWRITE(1, SO); __syncthreads();
  for (int j = 1; j + 1 < NT; j += 2) {
    SBAR(); qkt(pB0, pB1, K_lds + SHM_T, qr, r32, hi, cb0);
    finishSM(pA0, pA1, alA, l_reg, pa0, pa1, pa2, pa3); SBAR();
    SLOAD(SO, (j + 2) * KVBLK); SBAR();
    pv_d0(o, vb0, pa0, pa1, pa2, pa3); partialSM(pB0, pB1, m_reg, mnB, alB);
    __syncthreads(); SWAIT(); SWRITE(0, SE);
    RESC(alB); __syncthreads();
    SBAR(); qkt(pA0, pA1, K_lds, qr, r32, hi, cb0);
    finishSM(pB0, pB1, alB, l_reg, pa0, pa1, pa2, pa3); SBAR();
    if (j + 3 < NT) SLOAD(SE, (j + 3) * KVBLK); SBAR();
    pv_d0(o, vb0 + SHM_T, pa0, pa1, pa2, pa3); partialSM(pA0, pA1, m_reg, mnA, alA);
    __syncthreads(); SWAIT(); SWRITE(1, SO);
    RESC(alA); __syncthreads();
  }
  SBAR(); qkt(pB0, pB1, K_lds + SHM_T, qr, r32, hi, cb0);
  finishSM(pA0, pA1, alA, l_reg, pa0, pa1, pa2, pa3); SBAR();
  pv_d0(o, vb0, pa0, pa1, pa2, pa3); partialSM(pB0, pB1, m_reg, mnB, alB);
  __syncthreads(); RESC(alB);
  finishSM(pB0, pB1, alB, l_reg, pa0, pa1, pa2, pa3); SBAR();
  pv_d0(o, vb0 + SHM_T, pa0, pa1, pa2, pa3);
  if (hi == 0) li_l[r32] = l_reg; asm volatile("s_waitcnt lgkmcnt(0)" ::: "memory");
#pragma unroll
  for (int r = 0; r < 16; ++r) { const float rl = __builtin_amdgcn_rcpf(li_l[crow(r, hi)]);
#pragma unroll
    for (int d0 = 0; d0 < 4; ++d0) o[d0][r] *= rl; }
  combine_store<0>(o, lam, subg, zb, ob, lds);
#undef SLOAD
#undef SWRITE
#undef SWAIT
#undef RESC
}

__device__ __forceinline__ bf16x8 scale8(bf16x8 x, float s) {
  const u32x4 w = __builtin_bit_cast(u32x4, x); u32x4 o;
  o.x = cvt_pk_bf16(bf_lo(w.x) * s, bf_hi(w.x) * s); o.y = cvt_pk_bf16(bf_lo(w.y) * s, bf_hi(w.y) * s);
  o.z = cvt_pk_bf16(bf_lo(w.z) * s, bf_hi(w.z) * s); o.w = cvt_pk_bf16(bf_lo(w.w) * s, bf_hi(w.w) * s);
  return __builtin_bit_cast(bf16x8, o);
}

__device__ __forceinline__ void ret_local_unit(const bf16_t* Kp, const bf16_t* Vp, float l2f, float l2b, float* Lout, char* lds) {
  const int tid = threadIdx.x, wid = __builtin_amdgcn_readfirstlane(tid >> 6), lane = tid & 63, r32 = lane & 31, hi = lane >> 5;
  char* Kimg = lds; char* Vimg = lds + 2 * SHM_T;
  const int sr = tid >> 4, sc = (tid & 15) * 8, dir = sc >> 6, kc = sc & 63;
#pragma unroll
  for (int t = 0; t < 2; ++t)
#pragma unroll
    for (int rr = 0; rr < 2; ++rr) { const int row = sr + 32 * rr, j = 64 * t + row;
      const bf16x8 v = *(const bf16x8*)(Vp + (size_t)j * 1024 + sc);
      const bf16x8 k = *(const bf16x8*)(Kp + (size_t)j * 512 + kc);
      const float dec = dir == 0 ? __builtin_amdgcn_exp2f(l2f * (float)(127 - j)) : __builtin_amdgcn_exp2f(l2b * (float)j);
      *(bf16x8*)(Vimg + t * SHM_T + v_st(row, sc)) = v;
      *(bf16x8*)(Kimg + t * SHM_T + v_st(row, sc)) = scale8(k, dec); }
  __syncthreads();
  const int ra = wid >> 1, cb = (wid & 1) * 2;
  const int vrd = v_rd_base(lane);
  f32x16 acc0 = {}, acc1 = {};
#pragma unroll
  for (int t = 0; t < 2; ++t) {
    bf16x8 af[4]; tr_frag4(af, (int)(uintptr_t)(Kimg + t * SHM_T) + vrd + 512 * ra);
    pv_blk(acc0, (int)(uintptr_t)(Vimg + t * SHM_T) + vrd + 512 * cb, af[0], af[1], af[2], af[3]);
    pv_blk(acc1, (int)(uintptr_t)(Vimg + t * SHM_T) + vrd + 512 * (cb + 1), af[0], af[1], af[2], af[3]);
  }
  float* Lo = Lout + (size_t)((ra >> 1) * 64 + 32 * (ra & 1)) * 128 + 32 * cb + r32;
#pragma unroll
  for (int r = 0; r < 16; ++r) { Lo[crow(r, hi) * 128] = acc0[r]; Lo[crow(r, hi) * 128 + 32] = acc1[r]; }
  __syncthreads();
}

__device__ __forceinline__ void ret_out_unit(const bf16_t* Qp, const bf16_t* Kp, const bf16_t* Vp, const bf16_t* Pf, const bf16_t* Pb, float l2f, float l2b,
                                             const float* gain, const bf16_t* zb, bf16_t* ob, char* lds) {
  const int tid = threadIdx.x, wid = __builtin_amdgcn_readfirstlane(tid >> 6), lane = tid & 63, r32 = lane & 31, hi = lane >> 5, qblk = wid & 3, kt = wid >> 2;
  char* Kimg = lds; char* Vimg = lds + SHM_T; char* Pimg = lds + 3 * SHM_T;
  { const int row = tid >> 3, c8 = (tid & 7) * 8;
#pragma unroll
    for (int rr = 0; rr < 2; ++rr) { const int rw = row + 64 * rr; *(bf16x8*)(Kimg + KSWZ64(rw, c8 * 2)) = *(const bf16x8*)(Kp + (size_t)rw * 512 + c8); } }
  { const int sr = tid >> 4, sc = (tid & 15) * 8;
#pragma unroll
    for (int t = 0; t < 2; ++t)
#pragma unroll
      for (int rr = 0; rr < 2; ++rr) { const int row = sr + 32 * rr;
        *(bf16x8*)(Vimg + t * SHM_T + v_st(row, sc)) = *(const bf16x8*)(Vp + (size_t)(64 * t + row) * 1024 + sc);
        *(bf16x8*)(Pimg + t * SHM_T + v_st(row, sc)) = *(const bf16x8*)((t == 0 ? Pf : Pb) + row * 128 + sc); } }
  const int i = 32 * qblk + r32;
  bf16x8 qr[4];
#pragma unroll
  for (int d0 = 0; d0 < 4; ++d0) qr[d0] = *(const bf16x8*)(Qp + (size_t)i * 512 + d0 * 16 + hi * 8);
  __syncthreads();
  f32x16 p0 = {}, p1 = {};
#pragma unroll
  for (int d0 = 0; d0 < 4; ++d0) { const int cb = (d0 * 16 + hi * 8) * 2;
    const bf16x8 b0 = *(const bf16x8*)(Kimg + KSWZ64(64 * kt + r32, cb));
    const bf16x8 b1 = *(const bf16x8*)(Kimg + KSWZ64(64 * kt + 32 + r32, cb));
    p0 = __builtin_amdgcn_mfma_f32_32x32x16_bf16(b0, qr[d0], p0, 0, 0, 0);
    p1 = __builtin_amdgcn_mfma_f32_32x32x16_bf16(b1, qr[d0], p1, 0, 0, 0); }
#pragma unroll
  for (int r = 0; r < 16; ++r) { const int j0 = 64 * kt + crow(r, hi); const int d0 = i - j0, d1 = d0 - 32;
    const float w0 = d0 > 0 ? __builtin_amdgcn_exp2f(l2f * (float)d0) : (d0 < 0 ? __builtin_amdgcn_exp2f(l2b * (float)(-d0)) : 2.f);
    const float w1 = d1 > 0 ? __builtin_amdgcn_exp2f(l2f * (float)d1) : (d1 < 0 ? __builtin_amdgcn_exp2f(l2b * (float)(-d1)) : 2.f);
    p0[r] *= w0; p1[r] *= w1; }
  bf16x8 pa0, pa1, pa2, pa3; packP(p0, p1, pa0, pa1, pa2, pa3);
  f32x16 o[4] = {};
  const int vrd = v_rd_base(lane);
  pv_d0(o, (int)(uintptr_t)(Vimg + kt * SHM_T) + vrd, pa0, pa1, pa2, pa3);
  const float qs = kt == 0 ? __builtin_amdgcn_exp2f(l2f * (float)(i + 1)) : __builtin_amdgcn_exp2f(l2b * (float)(128 - i));
  pv_d0(o, (int)(uintptr_t)(Pimg + kt * SHM_T) + vrd, scale8(qr[0], qs), scale8(qr[1], qs), scale8(qr[2], qs), scale8(qr[3], qs));
  combine_store<1>(o, 0.f, gain, zb, ob, lds);
}
#undef SBAR
}
typedef GAS unsigned gu32;
typedef GAS unsigned long long gu64;
#define RLX_AGENT __ATOMIC_RELAXED, __HIP_MEMORY_SCOPE_AGENT
#define LDS_WAIT() asm volatile("s_waitcnt lgkmcnt(0)" ::: "memory")
#define VM_WAIT() asm volatile("s_waitcnt vmcnt(0)" ::: "memory")

#define XB_TMO      128
#define XB_XCNT(j)  (256  + 64 * (j))
#define XB_XSUB(j)  (1280 + 64 * (j))
#define XB_XGEN(j)  (2304 + 64 * (j))
#define XB_TOP      3328
#define XB_TOPGEN   3392
#define XCD_BAR_WORDS 3456
#define XB_SPIN_CAP (1u << 18)

__device__ __forceinline__ unsigned xb_ld(unsigned* p)              { return __hip_atomic_load(p, __ATOMIC_RELAXED, __HIP_MEMORY_SCOPE_AGENT); }
__device__ __forceinline__ unsigned xb_add(unsigned* p, unsigned v) { return __hip_atomic_fetch_add(p, v, __ATOMIC_RELAXED, __HIP_MEMORY_SCOPE_AGENT); }
__device__ __forceinline__ unsigned xb_xcc_id() { return (unsigned)__builtin_amdgcn_s_getreg((3 << 11) | 20) & 0xFu; }
#define XB_SPIN(cond, bar) do { unsigned _sp = 0; while (cond) { __builtin_amdgcn_s_sleep(1); \
    if ((++_sp & 255u) == 0u) { if (xb_ld(&(bar)[XB_TMO])) break; if (_sp > XB_SPIN_CAP) { atomicAdd(&(bar)[XB_TMO], 1u); break; } } } } while (0)

struct XcdBarrier {
    unsigned* bar; unsigned x;
    volatile LAS unsigned* st;
};

__device__ __forceinline__ XcdBarrier xcd_barrier_post(unsigned* bar, volatile LAS unsigned* st) {
    XcdBarrier b; b.bar = bar; b.x = xb_xcc_id(); b.st = st;
    if (threadIdx.x == 0) (void)xb_add(&bar[XB_XCNT(b.x)], 1u);
    return b;
}
__device__ __forceinline__ void xcd_barrier_complete(unsigned* bar, unsigned x, unsigned& nloc, unsigned& nx) {
    const unsigned G = gridDim.x * gridDim.y * gridDim.z;
    unsigned sum, cnt, mine, sp = 0u;
    for (;;) {
        sum = 0u; cnt = 0u; mine = 0u;
#pragma unroll
        for (unsigned j = 0; j < 16; ++j) { const unsigned c = xb_ld(&bar[XB_XCNT(j)]); sum += c; cnt += (c > 0u) ? 1u : 0u; mine = (j == x) ? c : mine; }
        if (sum == G) break;
        __builtin_amdgcn_s_sleep(1);
        if ((++sp & 255u) == 0u) { if (xb_ld(&bar[XB_TMO])) break; if (sp > XB_SPIN_CAP) { atomicAdd(&bar[XB_TMO], 1u); break; } }
    }
    nloc = mine > 0u ? mine : 1u; nx = cnt > 0u ? cnt : 1u;
}

__device__ __forceinline__ void xcd_barrier(const XcdBarrier& b) {
    asm volatile("s_waitcnt vmcnt(0)" ::: "memory");
    __syncthreads();
    if (threadIdx.x == 0) {
        unsigned* bar = b.bar;
        __builtin_amdgcn_s_waitcnt(0);
        unsigned nloc = b.st[0], nx = b.st[1];
        if (nloc == 0u) { xcd_barrier_complete(bar, b.x, nloc, nx); b.st[0] = nloc; b.st[1] = nx; }
        const unsigned old = xb_add(&bar[XB_XSUB(b.x)], 1u);
        const unsigned gen = old / nloc;
        if (old + 1u == (gen + 1u) * nloc) {
            __builtin_amdgcn_fence(__ATOMIC_RELEASE, "agent");
            asm volatile("s_waitcnt vmcnt(0)" ::: "memory");
            const unsigned og = xb_add(&bar[XB_TOP], 1u);
            const unsigned tg = og / nx;
            if (og + 1u == (tg + 1u) * nx) xb_add(&bar[XB_TOPGEN], 1u);
            else XB_SPIN(xb_ld(&bar[XB_TOPGEN]) == tg, bar);
            __builtin_amdgcn_fence(__ATOMIC_ACQUIRE, "agent");
            xb_add(&bar[XB_XGEN(b.x)], 1u);
            asm volatile("s_waitcnt vmcnt(0)" ::: "memory");
        } else {
            XB_SPIN(xb_ld(&bar[XB_XGEN(b.x)]) == gen, bar);
            __builtin_amdgcn_fence(__ATOMIC_ACQUIRE, "agent");
            asm volatile("s_waitcnt vmcnt(0)" ::: "memory");
        }
    }
    __syncthreads();
}

#ifndef MK_N_LAUNCHES
#define MK_N_LAUNCHES 1
#endif
#ifndef REP_P0A
#define REP_P0A 1
#endif
#ifndef REP_P0B
#define REP_P0B 1
#endif
#ifndef REP_P1
#define REP_P1 1
#endif
#ifndef REP_P2A
#define REP_P2A 1
#endif
#ifndef REP_P2B
#define REP_P2B 1
#endif
#ifndef REP_P3
#define REP_P3 1
#endif
#ifndef REP_P4
#define REP_P4 1
#endif
#ifndef REP_P5
#define REP_P5 1
#endif
#ifndef REP_P6
#define REP_P6 1
#endif
#ifndef REP_P7
#define REP_P7 1
#endif
#define REPEAT(n) for (int rep_ = 0; rep_ < (n); ++rep_)
constexpr int N_PHASES = 9;
constexpr int NWAVES = 8;
constexpr size_t MiB = 1u << 20;
constexpr size_t WS_CTL = 0, CTL_ZERO_BYTES = 64 * 1024;
constexpr size_t WS_WCAT = 2 * MiB;
constexpr size_t WS_WPA = 20 * MiB, WS_WPR = 22 * MiB, WS_WOUT = 24 * MiB;
constexpr size_t WS_QA = 26 * MiB;
constexpr size_t WS_ZA = 50 * MiB;
constexpr size_t WS_QR = 74 * MiB, WS_KR = 86 * MiB;
constexpr size_t WS_VR = 98 * MiB;
constexpr size_t WS_ZR = 122 * MiB;
constexpr size_t WS_G = 146 * MiB;
constexpr size_t WS_KC = 194 * MiB, WS_VC = 202 * MiB;
constexpr size_t WS_KL = 210 * MiB, WS_VL = 228 * MiB;
constexpr size_t WS_PST = 194 * MiB;
constexpr size_t WS_MODP = 246 * MiB;
constexpr size_t WS_MODF = 247 * MiB;
constexpr size_t WS_ROPE = 247 * MiB + 64 * 1024;
constexpr size_t WS_MISC = 247 * MiB + 128 * 1024;
constexpr size_t WS_STATS = 248 * MiB;
constexpr size_t WS_END = 249 * MiB;
static_assert(WS_WCAT + (size_t)N_CAT * DM * 2 <= WS_WPA && WS_VL + (size_t)LAT_B * LAT_KEYS * 1024 * 2 <= WS_MODP && WS_PST + (size_t)768 * 2 * 8192 * 2 <= WS_MODP, "d_ws map");
constexpr size_t OUT_Y = 0, OUT_K = 12582912, OUT_V = 16777216, OUT_SF = 20971520, OUT_SB = 22020096, OUT_END = 23068672;
constexpr int CW_BAR = 1024;
constexpr int RING_BYTES = 131072, LDSCTL_OFF = RING_BYTES, MISC_OFF = LDSCTL_OFF + 320, LDS_BYTES = 147456;

__device__ __forceinline__ float wave_sum(float v) {
#pragma unroll
    for (int o = 1; o < 64; o <<= 1) v += __shfl_xor(v, o);
    return v;
}
__device__ __forceinline__ void p0_transpose_item(const float* W, int K, int N, bf16_t* WT, int row_off, LAS float* scr, int item, int lane) {
    const int nblk = N / 32, kb = item / nblk, nb = item % nblk, k0 = 64 * kb, n0 = 32 * nb;
#pragma unroll 8
    for (int i = 0; i < 32; ++i) { const int kk = 2 * i + (lane >> 5); scr[kk * 33 + (lane & 31)] = W[(size_t)(k0 + kk) * N + n0 + (lane & 31)]; }
    LDS_WAIT(); asm volatile("" ::: "memory");
    const int c = lane & 7;
#pragma unroll
    for (int j = 0; j < 4; ++j) { const int n = (lane >> 3) + 8 * j; const LAS float* s = scr + (8 * c) * 33 + n;
        u32x4 o; o.x = cvt_pk_bf16(s[0 * 33], s[1 * 33]); o.y = cvt_pk_bf16(s[2 * 33], s[3 * 33]); o.z = cvt_pk_bf16(s[4 * 33], s[5 * 33]); o.w = cvt_pk_bf16(s[6 * 33], s[7 * 33]);
        *(u32x4*)(WT + (size_t)(row_off + n0 + n) * K + k0 + 8 * c) = o; }
    LDS_WAIT(); asm volatile("" ::: "memory");
}
__device__ __forceinline__ void sincos_d(double a, double& s, double& c) {
    const double TWO_PI = 6.283185307179586476925286766559;
    const double n = __builtin_rint(a / TWO_PI); const double x = a - n * TWO_PI, x2 = x * x;
    double ts = 1.0, tc = 1.0, ss = 1.0, cc = 1.0;
#pragma unroll
    for (int k = 1; k <= 14; ++k) { tc *= -x2 / (double)((2 * k - 1) * (2 * k)); ts *= -x2 / (double)((2 * k) * (2 * k + 1)); cc += tc; ss += ts; }
    s = x * ss; c = cc;
}
__device__ __forceinline__ float log2_gamma(float rd) { return log1pf(-exp2f(rd)) * 1.4426950408889634f; }

struct Args { const float* in[22]; float* out; unsigned char* ws; int ph_lo, ph_hi; };

__global__ void __launch_bounds__(NWAVES * 64, 2) mk_fwd(Args args) {
    extern __shared__ __attribute__((aligned(16))) unsigned char lds[];
    LAS unsigned char* ldsl = (LAS unsigned char*)lds;
    const int tid = threadIdx.x, lane = tid & 63, wave = __builtin_amdgcn_readfirstlane(tid >> 6);
    const int G = gridDim.x; const int bx = blockIdx.x; const int vcu = (G % 8 == 0) ? (bx % 8) * (G / 8) + bx / 8 : bx;
    unsigned char* ws = args.ws; float* dout = args.out;
    gu32* ctl = (gu32*)(ws + WS_CTL);
    volatile LAS unsigned* MISC = (volatile LAS unsigned*)(ldsl + MISC_OFF);
    for (int u = tid; u < (LDS_BYTES - LDSCTL_OFF) / 4; u += NWAVES * 64) ((LAS unsigned*)(ldsl + LDSCTL_OFF))[u] = 0u;
    __syncthreads();
    const int lo = args.ph_lo, hi = args.ph_hi;
    XcdBarrier bar; bar.bar = (unsigned*)(ctl + CW_BAR); bar.x = 0; bar.st = nullptr;
    if (hi - lo > 1) bar = xcd_barrier_post((unsigned*)(ctl + CW_BAR), MISC + 8);
#ifndef PHASE_MASK
#define PHASE_MASK 0x1ff
#endif
#define IN(k) (((PHASE_MASK >> (k)) & 1) && lo <= (k) && (k) < hi)
#define SEAM(k) do { if (IN(k) && IN((k) + 1)) xcd_barrier(bar); } while (0)
    const float* x_prompt = args.in[0]; const float* x_sample = args.in[1]; const float* cache_k = args.in[2]; const float* cache_v = args.in[3];
    const float* st_f = args.in[4]; const float* st_b = args.in[5]; const float* c_lat = args.in[6]; const float* c_ctx = args.in[7];
    const float* w_mod = args.in[8]; const float* b_mod = args.in[9]; const float* w_in = args.in[10]; const float* lam_p = args.in[11];
    const float* subln_g = args.in[12]; const float* ret_decay = args.in[13]; const float* ret_gn_g = args.in[14];
    const float* w_pa = args.in[15]; const float* w_pr = args.in[16]; const float* w_gate = args.in[17]; const float* b_gate = args.in[18];
    const float* w_out = args.in[19]; const float* ln_g = args.in[20]; const float* ln_b = args.in[21];
    bf16_t* WCAT = (bf16_t*)(ws + WS_WCAT); bf16_t* WPA = (bf16_t*)(ws + WS_WPA); bf16_t* WPR = (bf16_t*)(ws + WS_WPR); bf16_t* WOUT = (bf16_t*)(ws + WS_WOUT);
    bf16_t* QA = (bf16_t*)(ws + WS_QA); bf16_t* ZA = (bf16_t*)(ws + WS_ZA); bf16_t* QR = (bf16_t*)(ws + WS_QR); bf16_t* KR = (bf16_t*)(ws + WS_KR);
    bf16_t* VR = (bf16_t*)(ws + WS_VR); bf16_t* ZR = (bf16_t*)(ws + WS_ZR); bf16_t* GT = (bf16_t*)(ws + WS_G);
    bf16_t* KC = (bf16_t*)(ws + WS_KC); bf16_t* VC = (bf16_t*)(ws + WS_VC); bf16_t* KL = (bf16_t*)(ws + WS_KL); bf16_t* VL = (bf16_t*)(ws + WS_VL);
    bf16_t* PST = (bf16_t*)(ws + WS_PST);
    float* MODP = (float*)(ws + WS_MODP); float* MODF = (float*)(ws + WS_MODF); float* ROPE = (float*)(ws + WS_ROPE); float* MISCW = (float*)(ws + WS_MISC); float* STATS = (float*)(ws + WS_STATS);
    bf16_t* HB = (bf16_t*)dout;
    float* LST = dout;
    const int gw = vcu * NWAVES + wave, NGW = G * NWAVES;
    const int gt = bx * (NWAVES * 64) + tid, NGT = G * NWAVES * 64;

    if (IN(0)) REPEAT(REP_P0A) {
        LAS float* scr = (LAS float*)(ldsl + wave * 16384);
        constexpr int I_MOD = 192, I_IN = 16 * (N_IN / 32), I_GT = 16 * (N_GATE / 32), I_SQ = 16 * 32;
        constexpr int NITEMS = I_MOD + I_IN + I_GT + 3 * I_SQ;
        for (int it = gw; it < NITEMS; it += NGW) {
            int r = it;
            if (r < I_MOD) {
                const int cg = r % 12, ks = r / 12;
                float sv[5];
                { const int k = 64 * ks + lane; sv[0] = silu_f(c_ctx[k]);
#pragma unroll
                  for (int j = 1; j < 5; ++j) sv[j] = silu_f(c_lat[(j - 1) * DM + k]); }
                f32x4 a[5];
#pragma unroll
                for (int j = 0; j < 5; ++j) a[j] = (f32x4){0.f, 0.f, 0.f, 0.f};
                const float* wp = w_mod + (size_t)(64 * ks) * 3072 + 256 * cg + 4 * lane;
#pragma unroll 8
                for (int kk = 0; kk < 64; ++kk) { const f32x4 w = *(const f32x4*)(wp + (size_t)kk * 3072);
#pragma unroll
                    for (int j = 0; j < 5; ++j) a[j] += w * __shfl(sv[j], kk); }
#pragma unroll
                for (int j = 0; j < 5; ++j) *(f32x4*)(MODP + ((size_t)ks * 5 + j) * 3072 + 256 * cg + 4 * lane) = a[j];
                continue; }
            r -= I_MOD;
            if (r < I_IN) { p0_transpose_item(w_in, DM, N_IN, WCAT, 0, scr, r, lane); continue; } r -= I_IN;
            if (r < I_GT) { p0_transpose_item(w_gate, DM, N_GATE, WCAT, N_IN, scr, r, lane); continue; } r -= I_GT;
            if (r < I_SQ) { p0_transpose_item(w_pa, DM, DM, WPA, 0, scr, r, lane); continue; } r -= I_SQ;
            if (r < I_SQ) { p0_transpose_item(w_pr, DM, DM, WPR, 0, scr, r, lane); continue; } r -= I_SQ;
            p0_transpose_item(w_out, DM, DM, WOUT, 0, scr, r, lane);
        }
        for (int i = gt; i < 2 * LAT_B * PAST * 128; i += NGT) {
            const int which = i / (LAT_B * PAST * 128), j = i % (LAT_B * PAST * 128), b = j / (PAST * 128), e = (j % (PAST * 128)) * 8;
            const float* src = (which ? cache_v : cache_k) + (size_t)b * PAST * 1024 + e;
            const f32x4 a = *(const f32x4*)src, c = *(const f32x4*)(src + 4);
            u32x4 w; w.x = cvt_pk_bf16(a[0], a[1]); w.y = cvt_pk_bf16(a[2], a[3]); w.z = cvt_pk_bf16(c[0], c[1]); w.w = cvt_pk_bf16(c[2], c[3]);
            *(u32x4*)((which ? VL : KL) + (size_t)b * LAT_KEYS * 1024 + e) = w;
        }
        if (gt < 1024) {
            const int p = gt >> 4, f = gt & 15;
            const float inv = exp2f(-(float)f * (13.287712379549449f / 16.0f));
            const float ang = (float)p * inv; double s, c; sincos_d((double)ang, s, c);
            ROPE[gt * 2] = (float)c; ROPE[gt * 2 + 1] = (float)s;
        }
        if (gt == 0) { float s1 = 0.f, s2 = 0.f; for (int i = 0; i < 64; ++i) { s1 += lam_p[i] * lam_p[64 + i]; s2 += lam_p[128 + i] * lam_p[192 + i]; }
            MISCW[0] = expf(s1) - expf(s2) + LAM_INIT; }
    }
    SEAM(0);

    if (IN(1)) REPEAT(REP_P0B) {
        LAS float* SS = (LAS float*)ldsl;
        const int rows_per = (MTOK + G - 1) / G, r0 = bx * rows_per, r1 = (r0 + rows_per < MTOK) ? r0 + rows_per : MTOK;
        if (r0 < MTOK) {
            const int mb0 = r0 < M_CTX ? 0 : 1 + ((r0 - M_CTX) >> 11), mb1 = (r1 - 1) < M_CTX ? 0 : 1 + ((r1 - 1 - M_CTX) >> 11);
            for (int i = tid; i < 4096; i += NWAVES * 64) { const int which = i >> 11, cidx = i & 2047, mb = which ? mb1 : mb0;
                float s = b_mod[cidx];
#pragma unroll
                for (int ks = 0; ks < 16; ++ks) s += MODP[((size_t)ks * 5 + mb) * 3072 + cidx];
                SS[i] = s; }
        }
        if (bx < 60 && tid < 256) {
            const int j = bx / 12, cidx = (bx % 12) * 256 + tid; float s = b_mod[cidx];
#pragma unroll
            for (int ks = 0; ks < 16; ++ks) s += MODP[((size_t)ks * 5 + j) * 3072 + cidx];
            MODF[j * 3072 + cidx] = s;
        }
        __syncthreads();
        if (r0 < MTOK) {
            const int mb0 = r0 < M_CTX ? 0 : 1 + ((r0 - M_CTX) >> 11);
            for (int m = r0 + wave; m < r1; m += NWAVES) {
                const float* xrow = m < M_CTX ? x_prompt + (size_t)m * DM : x_sample + (size_t)(m - M_CTX) * DM;
                const int mb = m < M_CTX ? 0 : 1 + ((m - M_CTX) >> 11);
                const LAS float* sp = SS + (mb == mb0 ? 0 : 2048);
                const f32x4* xr = (const f32x4*)xrow + lane;
                f32x4 v[4]; float s = 0.f;
#pragma unroll
                for (int j = 0; j < 4; ++j) { v[j] = xr[64 * j]; s += (v[j].x + v[j].y) + (v[j].z + v[j].w); }
                const float mean = wave_sum(s) * (1.f / DM); float s2 = 0.f;
#pragma unroll
                for (int j = 0; j < 4; ++j) { v[j] = v[j] - mean; s2 += (v[j].x * v[j].x + v[j].y * v[j].y) + (v[j].z * v[j].z + v[j].w * v[j].w); }
                const float rstd = 1.f / sqrtf(wave_sum(s2) * (1.f / DM) + MOD_EPS);
                u32x2* o8 = (u32x2*)(HB + (size_t)m * DM) + lane;
#pragma unroll
                for (int j = 0; j < 4; ++j) { const int cidx = 256 * j + 4 * lane;
                    const f32x4 sh = *(const LAS f32x4*)(sp + cidx), sc = *(const LAS f32x4*)(sp + 1024 + cidx);
                    const f32x4 hv = v[j] * rstd * (sc + 1.f) + sh;
                    u32x2 w; w.x = cvt_pk_bf16(hv[0], hv[1]); w.y = cvt_pk_bf16(hv[2], hv[3]); o8[64 * j] = w; }
            }
        }
        __syncthreads();
    }
    SEAM(1);

    if (IN(2)) {
        pg8::Gemm g{HB, WCAT, HB, WCAT, MTOK, N_CAT, DM}; pg8::StaticOrder S; S.init(MTOK, N_CAT, G, bx, REP_P1);
        pg8::EpiProj E{QA, ZA, QR, KR, VR, ZR, GT, KC, VC, KL, VL, dout + OUT_K, dout + OUT_V, ROPE, b_gate};
        pg8::gemm_phase<pg8::EpiProj, pg8::StaticOrder, true, true>(ldsl, g, S, E);
    }
    SEAM(2);

    if (IN(3)) {
        const float lam = MISCW[0];
        constexpr int N_LAT_U = LAT_B * NH * (LAT_N / 128), N_CTX_U = CTX_B * NH * (CTX_N / 128), N_R1 = NCHUNK * NH;
        REPEAT(REP_P2A) for (int it = vcu; it < N_LAT_U + N_CTX_U; it += G) {
            size_t qoff, koff; const bf16_t* Kb; const bf16_t* Vb; int seq;
            if (it < N_LAT_U) {
                const int bh = it >> 4, qb = it & 15, b = bh >> 3, h = bh & 7;
                qoff = ((size_t)(M_CTX + b * LAT_N + qb * 128)) * 1024 + h * 128; koff = (size_t)b * LAT_KEYS * 1024 + h * 128; Kb = KL; Vb = VL; seq = LAT_KEYS;
            } else {
                const int u = it - N_LAT_U, bh = u >> 1, qb = u & 1, b = bh >> 3, h = bh & 7;
                qoff = ((size_t)(b * CTX_N + qb * 128)) * 1024 + h * 128; koff = (size_t)b * CTX_N * 1024 + h * 128; Kb = KC; Vb = VC; seq = CTX_N;
            }
            att::attn_unit(QA + qoff, Kb + koff, Vb + koff, seq, lam, subln_g, ZA + qoff, (rep_ + 1 < REP_P2A) ? (bf16_t*)(ws + WS_END) : QA + qoff, (char*)lds);
        }
        REPEAT(REP_P2B) for (int u = vcu; u < N_R1; u += G) {
            const int gc = u >> 3, h = u & 7;
            att::ret_local_unit(KR + (size_t)gc * 128 * 512 + h * 64, VR + (size_t)gc * 128 * 1024 + h * 128, log2_gamma(ret_decay[h]), log2_gamma(ret_decay[8 + h]), LST + (size_t)u * 16384, (char*)lds);
        }
    }
    SEAM(3);

    if (IN(4)) REPEAT(REP_P3) {
        for (int idx = gt; idx < 160 * 4096; idx += NGT) {
            const int chain = idx >> 12, rem = idx & 4095, dir = rem >> 11, e = (rem & 2047) * 4;
            int b, h, nc, gc0; f32x4 S;
            if (chain < 128) { b = chain >> 3; h = chain & 7; nc = 2; gc0 = b * 2; S = (f32x4){0.f, 0.f, 0.f, 0.f}; }
            else { const int cb = chain - 128; b = cb >> 3; h = cb & 7; nc = 16; gc0 = 32 + b * 16; S = *(const f32x4*)((dir ? st_b : st_f) + (size_t)(b * 8 + h) * 8192 + e); }
            const float dec = exp2f(log2_gamma(ret_decay[dir * 8 + h]) * 128.f);
            for (int cc = 0; cc < nc; ++cc) {
                const int c = dir ? nc - 1 - cc : cc; const size_t u = (size_t)(gc0 + c) * 8 + h;
                u32x2 w; w.x = cvt_pk_bf16(S[0], S[1]); w.y = cvt_pk_bf16(S[2], S[3]);
                *(u32x2*)(PST + (u * 2 + dir) * 8192 + e) = w;
                S = S * dec + *(const f32x4*)(LST + u * 16384 + dir * 8192 + e);
            }
            if (chain < 128) *(f32x4*)(dout + (dir ? OUT_SB : OUT_SF) + (size_t)(b * 8 + h) * 8192 + e) = S;
        }
    }
    SEAM(4);

    if (IN(5)) REPEAT(REP_P4) {
        for (int u = vcu; u < NCHUNK * NH; u += G) {
            const int gc = u >> 3, h = u & 7; const size_t t0 = (size_t)gc * 128;
            att::ret_out_unit(QR + t0 * 512 + h * 64, KR + t0 * 512 + h * 64, VR + t0 * 1024 + h * 128, PST + ((size_t)u * 2) * 8192, PST + ((size_t)u * 2 + 1) * 8192,
                              log2_gamma(ret_decay[h]), log2_gamma(ret_decay[8 + h]), ret_gn_g + h * 128, ZR + t0 * 1024 + h * 128, (rep_ + 1 < REP_P4) ? (bf16_t*)(ws + WS_END) : VR + t0 * 1024 + h * 128, (char*)lds);
        }
    }
    SEAM(5);

    if (IN(6)) {
        pg8::Gemm g{QA, WPA, VR, WPR, MTOK, DM, DM}; pg8::PanelOrder<true> S{bx, REP_P5};
        pg8::EpiMerge E{GT, ZA};
        pg8::gemm_phase<pg8::EpiMerge, pg8::PanelOrder<true>, true, true>(ldsl, g, S, E);
    }
    SEAM(6);

    if (IN(7)) {
        pg8::Gemm g{ZA, WOUT, ZA, WOUT, MTOK, DM, DM}; pg8::PanelOrder<false> S{bx, 1};
        pg8::EpiOut E{x_prompt, x_sample, MODF, dout + OUT_Y, STATS};
        pg8::gemm_phase<pg8::EpiOut, pg8::PanelOrder<false>, false, true>(ldsl, g, S, E);
    }
    SEAM(7);

    if (IN(8)) REPEAT(REP_P7) {
        for (int m = gw; m < MTOK; m += NGW) {
            const f32x4 s0 = *(const f32x4*)(STATS + (size_t)m * 8), s1 = *(const f32x4*)(STATS + (size_t)m * 8 + 4);
            const float mean = (s0[0] + s0[2] + s1[0] + s1[2]) * 0.25f;
            const float d0 = s0[0] - mean, d1 = s0[2] - mean, d2 = s1[0] - mean, d3 = s1[2] - mean;
            const float m2 = (s0[1] + s0[3]) + (s1[1] + s1[3]) + 256.f * ((d0 * d0 + d1 * d1) + (d2 * d2 + d3 * d3));
            const float rstd = 1.f / sqrtf(m2 * (1.f / DM) + LN_EPS);
            f32x4* yr = (f32x4*)(dout + OUT_Y + (size_t)m * DM) + lane;
            f32x4* yw = (rep_ + 1 < REP_P7) ? (f32x4*)(ws + WS_END) + lane : yr;
#pragma unroll
            for (int j = 0; j < 4; ++j) { const int cidx = 256 * j + 4 * lane; const f32x4 v = yr[64 * j];
                yw[64 * j] = (v - mean) * rstd * *(const f32x4*)(ln_g + cidx) + *(const f32x4*)(ln_b + cidx); }
        }
    }
#undef IN
#undef SEAM
}

extern "C" void kernel_launch(void* const* d_in, const int* in_sizes, int n_in, void* d_out, int out_size, void* d_ws, size_t ws_size, hipStream_t stream) {
    static int grid = 0;
    if (grid == 0) {
        if (n_in != 22 || out_size != (int)OUT_END || ws_size < WS_END) { fprintf(stderr, "kernel_launch: unexpected shapes: n_in %d out %d ws %zu (need >= %zu); nothing launched\n", n_in, out_size, ws_size, (size_t)WS_END); grid = -1; return; }
        int dev = 0, cus = 0, per_cu = 0;
        if (hipGetDevice(&dev) != hipSuccess || hipDeviceGetAttribute(&cus, hipDeviceAttributeMultiprocessorCount, dev) != hipSuccess) { fprintf(stderr, "kernel_launch: device query failed\n"); grid = -1; return; }
        if (hipFuncSetAttribute((const void*)mk_fwd, hipFuncAttributeMaxDynamicSharedMemorySize, LDS_BYTES) != hipSuccess) { fprintf(stderr, "kernel_launch: hipFuncSetAttribute failed\n"); grid = -1; return; }
        if (hipOccupancyMaxActiveBlocksPerMultiprocessor(&per_cu, (const void*)mk_fwd, NWAVES * 64, LDS_BYTES) != hipSuccess || per_cu < 1) {
            fprintf(stderr, "kernel_launch: occupancy query reports %d workgroups per CU\n", per_cu); }
        (void)hipGetLastError();
        grid = cus;
        if (grid != 256) fprintf(stderr, "kernel_launch: %d CUs; the panel phases expect 256\n", grid);
    }
    if (grid < 0) return;
    (void)hipMemsetAsync((char*)d_ws + WS_CTL, 0, CTL_ZERO_BYTES, stream);
    Args a{};
    for (int i = 0; i < 22; ++i) a.in[i] = (const float*)d_in[i];
    a.out = (float*)d_out; a.ws = (unsigned char*)d_ws;
#if MK_N_LAUNCHES == 1
    a.ph_lo = 0; a.ph_hi = N_PHASES;
    hipLaunchKernelGGL(mk_fwd, dim3(grid), dim3(NWAVES * 64), LDS_BYTES, stream, a);
#else
    for (int p = 0; p < N_PHASES; ++p) { a.ph_lo = p; a.ph_hi = p + 1; hipLaunchKernelGGL(mk_fwd, dim3(grid), dim3(NWAVES * 64), LDS_BYTES, stream, a); }
#endif
    const hipError_t le = hipPeekAtLastError();
    if (le != hipSuccess) fprintf(stderr, "kernel_launch: launch failed: %s\n", hipGetErrorName(le));
}
```

```cpp
#include <hip/hip_runtime.h>
#include <cstdio>
#include <cstdint>

#define GAS __attribute__((address_space(1)))
#define LAS __attribute__((address_space(3)))
typedef unsigned short bf16_t;
typedef short bf16x8 __attribute__((ext_vector_type(8)));
typedef short s16x4 __attribute__((ext_vector_type(4)));
typedef float f32x2 __attribute__((ext_vector_type(2)));
typedef float f32x4 __attribute__((ext_vector_type(4)));
typedef float f32x8 __attribute__((ext_vector_type(8)));
typedef float f32x16 __attribute__((ext_vector_type(16)));
typedef unsigned u32x2 __attribute__((ext_vector_type(2)));
typedef unsigned u32x4 __attribute__((ext_vector_type(4)));

constexpr int DM = 1024;
constexpr int M_CTX = 4096, M_LAT = 8192, MTOK = M_CTX + M_LAT;
constexpr int N_IN = 7168, N_GATE = 2048, N_CAT = N_IN + N_GATE;
constexpr int NH = 8;
constexpr int CTX_B = 16, CTX_N = 256, LAT_B = 4, LAT_N = 2048, PAST = 256, LAT_KEYS = PAST + LAT_N;
constexpr int NCHUNK = MTOK / 128;
constexpr float LN_EPS = 1e-5f, MOD_EPS = 1e-6f;
constexpr float DN_ALPHA = 1.189207115002721f;
constexpr float LAM_INIT = 0.2f;

__device__ __forceinline__ unsigned cvt_pk_bf16(float lo, float hi) { unsigned r; asm volatile("v_cvt_pk_bf16_f32 %0, %1, %2" : "=v"(r) : "v"(lo), "v"(hi)); return r; }
__device__ __forceinline__ float bf_lo(unsigned w) { return __uint_as_float(w << 16); }
__device__ __forceinline__ float bf_hi(unsigned w) { return __uint_as_float(w & 0xffff0000u); }
__device__ __forceinline__ float bf2f(bf16_t h) { return __uint_as_float((unsigned)h << 16); }
__device__ __forceinline__ float fast_rcp(float x) { return __builtin_amdgcn_rcpf(x); }
__device__ __forceinline__ float silu_f(float v) { return v * fast_rcp(1.f + __builtin_amdgcn_exp2f(-1.4426950408889634f * v)); }
__device__ __forceinline__ float sigmoid_f(float v) { return fast_rcp(1.f + __builtin_amdgcn_exp2f(-1.4426950408889634f * v)); }

namespace pg8 {
#define PG8_LAS __attribute__((address_space(3)))
constexpr int BM = 256, BK = 64, HALF = 128, HTB = HALF * BK * 2  , STAGE_BYTES = 8 * HTB, NXCD = 8, WGM = 8;

__host__ __device__ __forceinline__ int lds_byte(int r, int c) { const int st = (r >> 4) * 2 + (c >> 5), rr = r & 15, cc = c & 31, ob = rr * 64 + cc * 2; return st * 1024 + (ob ^ (((ob >> 9) & 1) << 5)); }
__host__ __device__ __forceinline__ void stage_rc(int b, int& R, int& C) { const int st = b / 1024, sb = b % 1024, swz = sb ^ (((sb >> 9) & 1) << 5); R = (st >> 1) * 16 + swz / 64; C = (st & 1) * 32 + (swz % 64) / 2; }
__host__ __device__ __forceinline__ int perm32(int rho) { const int n = rho >> 4, i = rho & 15; return 8 * (i >> 2) + 4 * n + (i & 3); }

struct Unit { int pm, pn, sel; };
struct Gemm { const bf16_t* A; const bf16_t* Bt; const bf16_t* A2; const bf16_t* Bt2; int M, N, K; };

struct StaticOrder {
    int nM, nN, nwg, G, c, rep;
    __host__ __device__ void init(int M, int N, int G_, int c_, int rep_ = 1) { nM = M / BM; nN = N / BM; nwg = nM * nN; G = G_; c = c_; rep = rep_; }
    __host__ __device__ bool next(int i, Unit& u) const {
        long L = (long)i * G + c; if (L >= (long)nwg * rep) return false;
        L %= nwg;
        int wgid = (int)L; { const int q = nwg / NXCD, r = nwg % NXCD, xcd = wgid % NXCD, off = wgid / NXCD; wgid = (xcd < r ? xcd * (q + 1) : r * (q + 1) + (xcd - r) * q) + off; }
        const int nig = WGM * nN, gid = wgid / nig, fm = gid * WGM, gsz = (nM - fm) < WGM ? (nM - fm) : WGM;
        u.pm = fm + ((wgid % nig) % gsz); u.pn = (wgid % nig) / gsz; u.sel = 0; return true;
    }
    __device__ __forceinline__ void a_ready(const Unit&) const {}
    __device__ __forceinline__ void done(const Unit&) const {}
};
template <bool PAIR> struct PanelOrder {
    int c, rep;
    __device__ __forceinline__ bool next(int i, Unit& u) const {
        const int xcd = c & 7, idx = c >> 3;
        if (idx >= 24 || i >= (PAIR ? 2 : 1) * rep) return false;
        u.pm = xcd * 6 + (idx >> 2); u.pn = idx & 3; u.sel = PAIR ? (i & 1) : 0; return true;
    }
    __device__ __forceinline__ void a_ready(const Unit&) const {}
    __device__ __forceinline__ void done(const Unit&) const {}
};


struct EpiProj {
    static constexpr bool PERM = true, AFTER_DRAIN = false;
    __device__ static __forceinline__ bool keep_acc(const Unit&) { return false; }
    bf16_t *QA, *ZA, *QR, *KR, *VR, *ZR, *G, *KC, *VC, *KL, *VL;
    float *outK, *outV; const float* rope; const float* b_gate;
    __device__ __forceinline__ static void st8(bf16_t* p, const f32x4& a, const f32x4& b) {
        u32x4 w; w.x = cvt_pk_bf16(a[0], a[1]); w.y = cvt_pk_bf16(a[2], a[3]); w.z = cvt_pk_bf16(b[0], b[1]); w.w = cvt_pk_bf16(b[2], b[3]); *(u32x4*)p = w; }
    __device__ __forceinline__ void rope8(f32x4& a, f32x4& b, int pos, int dcol) const {
        const int i0 = dcol >> 1, p = (i0 < 16) ? (pos >> 6) : (pos & 63), f0 = i0 & 15;
        const f32x4 t0 = *(const f32x4*)(rope + (p * 16 + f0) * 2), t1 = *(const f32x4*)(rope + (p * 16 + f0) * 2 + 4);
        f32x4 ra, rb;
        ra[0] = a[0] * t0[0] - a[1] * t0[1]; ra[1] = a[0] * t0[1] + a[1] * t0[0]; ra[2] = a[2] * t0[2] - a[3] * t0[3]; ra[3] = a[2] * t0[3] + a[3] * t0[2];
        rb[0] = b[0] * t1[0] - b[1] * t1[1]; rb[1] = b[0] * t1[1] + b[1] * t1[0]; rb[2] = b[2] * t1[2] - b[3] * t1[3]; rb[3] = b[2] * t1[3] + b[3] * t1[2];
        a = ra; b = rb;
    }
    __device__ __forceinline__ void operator()(f32x4 (&acc)[2][2][4][2], const Unit& u, int wr, int wc, int fr, int fq) const {
        const int pn = u.pn; const bool ctx = u.pm < (M_CTX / BM);
        const int row0 = u.pm * BM + wr * 64 + fr;
        int seg, cs0;
        if (pn < 4) { seg = 0; cs0 = pn * 256; } else if (pn < 8) { seg = 1; cs0 = (pn - 4) * 256; } else if (pn < 12) { seg = 2; cs0 = (pn - 8) * 256; }
        else if (pn < 16) { seg = 3; cs0 = (pn - 12) * 256; } else if (pn < 18) { seg = 4; cs0 = (pn - 16) * 256; } else if (pn < 20) { seg = 5; cs0 = (pn - 18) * 256; }
        else if (pn < 24) { seg = 6; cs0 = (pn - 20) * 256; } else if (pn < 28) { seg = 7; cs0 = (pn - 24) * 256; } else { seg = 8; cs0 = (pn - 28) * 256; }
        const int colw = cs0 + wc * 32 + 8 * fq;
#pragma unroll
        for (int ai = 0; ai < 2; ++ai)
#pragma unroll
            for (int m = 0; m < 4; ++m) {
                const int row = row0 + ai * HALF + m * 16;
                const int lrow = row - M_CTX, lb = lrow >> 11, pos = lrow & (LAT_N - 1);
#pragma unroll
                for (int bj = 0; bj < 2; ++bj) {
                    const int col = colw + bj * HALF;
                    f32x4 v0 = acc[ai][bj][m][0], v1 = acc[ai][bj][m][1];
                    if (seg == 0) {
                        if (!ctx) rope8(v0, v1, pos, col & 63);
                        st8(QA + (size_t)row * 1024 + col, v0, v1);
                    } else if (seg == 1) {
                        if (ctx) { float* o = outK + (size_t)row * 1024 + col; *(f32x4*)o = v0; *(f32x4*)(o + 4) = v1; st8(KC + (size_t)row * 1024 + col, v0, v1); }
                        else { rope8(v0, v1, pos, col & 63); st8(KL + ((size_t)lb * LAT_KEYS + PAST + pos) * 1024 + col, v0, v1); }
                    } else if (seg == 2) {
                        if (ctx) { float* o = outV + (size_t)row * 1024 + col; *(f32x4*)o = v0; *(f32x4*)(o + 4) = v1; st8(VC + (size_t)row * 1024 + col, v0, v1); }
                        else st8(VL + ((size_t)lb * LAT_KEYS + PAST + pos) * 1024 + col, v0, v1);
                    } else if (seg == 3 || seg == 7) {
#pragma unroll
                        for (int k = 0; k < 4; ++k) { v0[k] = silu_f(v0[k]); v1[k] = silu_f(v1[k]); }
                        st8((seg == 3 ? ZA : ZR) + (size_t)row * 1024 + col, v0, v1);
                    } else if (seg == 4) {
                        st8(QR + (size_t)row * 512 + col, v0, v1);
                    } else if (seg == 5) {
                        v0 = v0 * 0.125f; v1 = v1 * 0.125f; st8(KR + (size_t)row * 512 + col, v0, v1);
                    } else if (seg == 6) {
                        st8(VR + (size_t)row * 1024 + col, v0, v1);
                    } else {
                        const f32x4 b0 = *(const f32x4*)(b_gate + col), b1 = *(const f32x4*)(b_gate + col + 4);
#pragma unroll
                        for (int k = 0; k < 4; ++k) { v0[k] = sigmoid_f(v0[k] + b0[k]); v1[k] = sigmoid_f(v1[k] + b1[k]); }
                        st8(G + (size_t)row * 2048 + col, v0, v1);
                    }
                }
            }
    }
};

struct EpiMerge {
    static constexpr bool PERM = true, AFTER_DRAIN = false;
    __device__ static __forceinline__ bool keep_acc(const Unit& u) { return u.sel == 0; }
    const bf16_t* G; bf16_t* Mo;
    __device__ __forceinline__ void operator()(f32x4 (&acc)[2][2][4][2], const Unit& u, int wr, int wc, int fr, int fq) const {
        const int row0 = u.pm * BM + wr * 64 + fr, col0 = u.pn * BM + wc * 32 + 8 * fq;
#pragma unroll
        for (int ai = 0; ai < 2; ++ai)
#pragma unroll
            for (int m = 0; m < 4; ++m) {
                const int row = row0 + ai * HALF + m * 16;
#pragma unroll
                for (int bj = 0; bj < 2; ++bj) {
                    const int col = col0 + bj * HALF;
                    const u32x4 gr = *(const u32x4*)(G + (size_t)row * 2048 + 1024 + col);
                    if (u.sel == 0) {
                        const u32x4 ga = *(const u32x4*)(G + (size_t)row * 2048 + col);
                        f32x4 r0, r1;
                        r0[0] = bf_lo(ga.x) * fast_rcp(bf_lo(gr.x)); r0[1] = bf_hi(ga.x) * fast_rcp(bf_hi(gr.x)); r0[2] = bf_lo(ga.y) * fast_rcp(bf_lo(gr.y)); r0[3] = bf_hi(ga.y) * fast_rcp(bf_hi(gr.y));
                        r1[0] = bf_lo(ga.z) * fast_rcp(bf_lo(gr.z)); r1[1] = bf_hi(ga.z) * fast_rcp(bf_hi(gr.z)); r1[2] = bf_lo(ga.w) * fast_rcp(bf_lo(gr.w)); r1[3] = bf_hi(ga.w) * fast_rcp(bf_hi(gr.w));
                        acc[ai][bj][m][0] = acc[ai][bj][m][0] * r0; acc[ai][bj][m][1] = acc[ai][bj][m][1] * r1;
                    } else {
                        f32x4 g0, g1;
                        g0[0] = bf_lo(gr.x); g0[1] = bf_hi(gr.x); g0[2] = bf_lo(gr.y); g0[3] = bf_hi(gr.y); g1[0] = bf_lo(gr.z); g1[1] = bf_hi(gr.z); g1[2] = bf_lo(gr.w); g1[3] = bf_hi(gr.w);
                        const f32x4 v0 = acc[ai][bj][m][0] * g0, v1 = acc[ai][bj][m][1] * g1;
                        u32x4 w; w.x = cvt_pk_bf16(v0[0], v0[1]); w.y = cvt_pk_bf16(v0[2], v0[3]); w.z = cvt_pk_bf16(v1[0], v1[1]); w.w = cvt_pk_bf16(v1[2], v1[3]);
                        *(u32x4*)(Mo + (size_t)row * 1024 + col) = w;
                    }
                }
            }
    }
};

struct EpiOut {
    static constexpr bool PERM = false, AFTER_DRAIN = true;
    __device__ static __forceinline__ bool keep_acc(const Unit&) { return false; }
    const float* xc; const float* xl; const float* modf; float* out; float* stats;
    __device__ __forceinline__ void operator()(f32x4 (&)[2][2][4][2], const Unit&, int, int, int, int) const {}
    __device__ __forceinline__ void fused(f32x4 (&acc)[2][2][4][2], const Unit& u, int wr, int wc, int fr, int fq, PG8_LAS unsigned char* lds, int wid, int lane) const {
        PG8_LAS f32x2* P = (PG8_LAS f32x2*)lds;
        const bool ctx = u.pm < (M_CTX / BM);
        const int mb = ctx ? 0 : 1 + ((u.pm * BM - M_CTX) >> 11);
        const float* xb = ctx ? xc + (size_t)(u.pm * BM) * DM : xl + (size_t)(u.pm * BM - M_CTX) * DM;
        const int col0 = u.pn * BM + wc * 32 + 4 * fq;
        f32x4 gv[2][2];
#pragma unroll
        for (int bj = 0; bj < 2; ++bj)
#pragma unroll
            for (int n = 0; n < 2; ++n) gv[bj][n] = *(const f32x4*)(modf + mb * 3072 + 2048 + col0 + bj * HALF + n * 16);
#pragma unroll
        for (int ai = 0; ai < 2; ++ai)
#pragma unroll
            for (int m = 0; m < 4; ++m) {
                const int rl = ai * HALF + wr * 64 + m * 16 + fr;
                float s = 0.f;
#pragma unroll
                for (int bj = 0; bj < 2; ++bj)
#pragma unroll
                    for (int n = 0; n < 2; ++n) {
                        const f32x4 xv = *(const f32x4*)(xb + (size_t)rl * DM + col0 + bj * HALF + n * 16);
                        const f32x4 v = xv * DN_ALPHA + gv[bj][n] * acc[ai][bj][m][n];
                        acc[ai][bj][m][n] = v; s += (v[0] + v[1]) + (v[2] + v[3]);
                        *(f32x4*)(out + (size_t)(u.pm * BM + rl) * DM + col0 + bj * HALF + n * 16) = v;
                    }
                s += __shfl_xor(s, 16); s += __shfl_xor(s, 32);
                const float mw = s * (1.0f / 64.0f); float q = 0.f;
#pragma unroll
                for (int bj = 0; bj < 2; ++bj)
#pragma unroll
                    for (int n = 0; n < 2; ++n) { const f32x4 d = acc[ai][bj][m][n] - mw; q += (d[0] * d[0] + d[1] * d[1]) + (d[2] * d[2] + d[3] * d[3]); }
                q += __shfl_xor(q, 16); q += __shfl_xor(q, 32);
                if (fq == 0) P[rl * 4 + wc] = (f32x2){mw, q};
            }
        asm volatile("s_waitcnt lgkmcnt(0)" ::: "memory"); __builtin_amdgcn_s_barrier(); asm volatile("" ::: "memory");
        const int row = wid * 32 + (lane & 31);
        if (lane < 32) {
            const f32x2 a = P[row * 4 + 0], b = P[row * 4 + 1], c = P[row * 4 + 2], d = P[row * 4 + 3];
            const float mt = (a.x + b.x + c.x + d.x) * 0.25f;
            const float da = a.x - mt, db = b.x - mt, dc = c.x - mt, dd = d.x - mt;
            const float m2 = (a.y + b.y) + (c.y + d.y) + 64.0f * ((da * da + db * db) + (dc * dc + dd * dd));
            *(f32x2*)(stats + ((size_t)(u.pm * BM + row) * 4 + u.pn) * 2) = (f32x2){mt, m2};
        }
    }
};

template <class Epi, class Sched, bool ALIGN_EPI = false, bool SP2 = false>
__device__ __forceinline__ void gemm_phase(PG8_LAS unsigned char* lds, const Gemm g, const Sched& S, const Epi& E) {
    const int tid = threadIdx.x, wid = __builtin_amdgcn_readfirstlane(tid >> 6), lane = tid & 63, wr = wid >> 2, wc = wid & 3, fr = lane & 15, fq = lane >> 4;
    const int K = g.K, nt = K / BK;
    unsigned voffA[2], voffB[2];
#pragma unroll
    for (int i = 0; i < 2; ++i) { int R, C; stage_rc(tid * 16 + i * 8192, R, C); const int Rb = Epi::PERM ? ((R & ~31) + perm32(R & 31)) : R;
        voffA[i] = (unsigned)(R * K + C) * 2u; voffB[i] = (unsigned)(Rb * K + C) * 2u; }
    const size_t kstep = (size_t)(BK * 2);
    const size_t hstep = (size_t)HALF * K * 2;
    const size_t tstep = 2 * hstep;
    const unsigned ldsw = (unsigned)wid * 1024u;
    const int aoff = lds_byte(wr * 64 + fr, fq * 8), boff = lds_byte(wc * 32 + fr, fq * 8);
#define PG8_SA(b, h) (((b) * 2 + (h)) * HTB)
#define PG8_SB(b, h) ((4 + (b) * 2 + (h)) * HTB)
#define PG8_STAGE(bufoff, gbase, voff) do { _Pragma("unroll") for (int _i = 0; _i < 2; ++_i) \
        __builtin_amdgcn_global_load_lds((const unsigned*)((const char*)(gbase) + (voff)[_i]), (PG8_LAS unsigned*)(lds + (bufoff) + ldsw + _i * 8192), 16, 0, 0); } while (0)
#define PG8_LDA(dst, b, h) do { _Pragma("unroll") for (int m = 0; m < 4; ++m) _Pragma("unroll") for (int k = 0; k < 2; ++k) dst[m][k] = *(const PG8_LAS bf16x8*)(lds + PG8_SA(b, h) + aoff + m * 2048 + k * 1024); } while (0)
#define PG8_LDB(dst, b, h) do { _Pragma("unroll") for (int n = 0; n < 2; ++n) _Pragma("unroll") for (int k = 0; k < 2; ++k) dst[n][k] = *(const PG8_LAS bf16x8*)(lds + PG8_SB(b, h) + boff + n * 2048 + k * 1024); } while (0)
#define PG8_MMA(ai, bj, At, Bt) do { __builtin_amdgcn_s_setprio(1); _Pragma("unroll") for (int m = 0; m < 4; ++m) _Pragma("unroll") for (int n = 0; n < 2; ++n) _Pragma("unroll") for (int k = 0; k < 2; ++k) \
        acc[ai][bj][m][n] = __builtin_amdgcn_mfma_f32_16x16x32_bf16(Bt[n][k], At[m][k], acc[ai][bj][m][n], 0, 0, 0); __builtin_amdgcn_s_setprio(0); } while (0)
#define PG8_WAIT_V(n) asm volatile("s_waitcnt vmcnt(" #n ")" ::: "memory")
#define PG8_WAIT_L(n) asm volatile("s_waitcnt lgkmcnt(" #n ")" ::: "memory")
#define PG8_BAR __builtin_amdgcn_s_barrier()
#define PG8_SCHED __builtin_amdgcn_sched_barrier(0)
    Unit cur, nxt; int ui = 0;
    if (!S.next(0, cur)) return;
    f32x4 acc[2][2][4][2];
#pragma unroll
    for (int a = 0; a < 2; ++a)
#pragma unroll
        for (int b = 0; b < 2; ++b)
#pragma unroll
            for (int m = 0; m < 4; ++m)
#pragma unroll
                for (int n = 0; n < 2; ++n) acc[a][b][m][n] = (f32x4){0.f, 0.f, 0.f, 0.f};
    bf16x8 At[4][2], B0[2][2], B1[2][2];
    const char* cA = (const char*)(cur.sel ? g.A2 : g.A) + (size_t)cur.pm * tstep; const char* cB = (const char*)(cur.sel ? g.Bt2 : g.Bt) + (size_t)cur.pn * tstep;
    S.a_ready(cur);
    if constexpr (SP2) {
        PG8_STAGE(PG8_SB(0, 0), cB, voffB); PG8_STAGE(PG8_SB(0, 1), cB + hstep, voffB); PG8_STAGE(PG8_SA(0, 0), cA, voffA); PG8_STAGE(PG8_SA(0, 1), cA + hstep, voffA);
        if (wr == 1) PG8_BAR;
        PG8_WAIT_V(2); PG8_BAR;
        PG8_STAGE(PG8_SB(1, 0), cB + kstep, voffB); PG8_STAGE(PG8_SA(1, 0), cA + kstep, voffA); PG8_STAGE(PG8_SB(1, 1), cB + hstep + kstep, voffB);
        PG8_WAIT_V(6); PG8_BAR;
    } else {
        PG8_STAGE(PG8_SB(0, 0), cB, voffB); PG8_STAGE(PG8_SA(0, 0), cA, voffA); PG8_STAGE(PG8_SB(0, 1), cB + hstep, voffB); PG8_STAGE(PG8_SA(0, 1), cA + hstep, voffA);
        if (wr == 1) PG8_BAR;
        PG8_WAIT_V(4); PG8_BAR;
        PG8_STAGE(PG8_SB(1, 0), cB + kstep, voffB); PG8_STAGE(PG8_SA(1, 0), cA + kstep, voffA); PG8_STAGE(PG8_SB(1, 1), cB + hstep + kstep, voffB);
        PG8_WAIT_V(6); PG8_BAR;
    }
    for (;;) {
        const bool has_next = S.next(ui + 1, nxt);
        const char* nA = has_next ? (const char*)(nxt.sel ? g.A2 : g.A) + (size_t)nxt.pm * tstep : cA; const char* nB = has_next ? (const char*)(nxt.sel ? g.Bt2 : g.Bt) + (size_t)nxt.pn * tstep : cB;
        for (int t = 0; t < nt; t += 2) {
            const bool last = (t == nt - 2);
            const char* a1 = cA + (size_t)(t + 1) * kstep;
            const char* a2 = last ? nA : cA + (size_t)(t + 2) * kstep; const char* b2 = last ? nB : cB + (size_t)(t + 2) * kstep;
            const char* a3 = a2 + kstep; const char* b3 = b2 + kstep;
            if (last && has_next) S.a_ready(nxt);
            if constexpr (SP2) {
            PG8_LDB(B0, 0, 0); PG8_LDB(B1, 0, 1); PG8_SCHED; PG8_LDA(At, 0, 0); PG8_STAGE(PG8_SA(1, 1), a1 + hstep, voffA);
            PG8_WAIT_V(8); PG8_WAIT_L(0); PG8_BAR; PG8_MMA(0, 0, At, B0); PG8_MMA(0, 1, At, B1); PG8_BAR; PG8_SCHED;
            PG8_LDA(At, 0, 1); PG8_STAGE(PG8_SB(0, 0), b2, voffB); PG8_STAGE(PG8_SB(0, 1), b2 + hstep, voffB); PG8_STAGE(PG8_SA(0, 0), a2, voffA);
            PG8_WAIT_V(8); PG8_WAIT_L(0); PG8_BAR; PG8_MMA(1, 0, At, B0); PG8_MMA(1, 1, At, B1); PG8_BAR; PG8_SCHED;
            PG8_LDB(B0, 1, 0); PG8_LDB(B1, 1, 1); PG8_SCHED; PG8_LDA(At, 1, 0); PG8_STAGE(PG8_SA(0, 1), a2 + hstep, voffA);
            PG8_WAIT_V(8); PG8_WAIT_L(0); PG8_BAR; PG8_MMA(0, 0, At, B0); PG8_MMA(0, 1, At, B1); PG8_BAR; PG8_SCHED;
            PG8_LDA(At, 1, 1); PG8_STAGE(PG8_SB(1, 0), b3, voffB); PG8_STAGE(PG8_SB(1, 1), b3 + hstep, voffB); PG8_STAGE(PG8_SA(1, 0), a3, voffA);
            PG8_WAIT_V(8); PG8_WAIT_L(0); PG8_BAR; PG8_MMA(1, 0, At, B0); PG8_MMA(1, 1, At, B1); PG8_BAR; PG8_SCHED;
            } else {
            PG8_LDB(B0, 0, 0); PG8_SCHED; PG8_LDA(At, 0, 0); PG8_STAGE(PG8_SA(1, 1), a1 + hstep, voffA);
            PG8_WAIT_L(8); PG8_BAR; PG8_WAIT_L(0); PG8_MMA(0, 0, At, B0); PG8_BAR; PG8_SCHED;
            PG8_LDB(B1, 0, 1); PG8_STAGE(PG8_SB(0, 0), b2, voffB);
            PG8_BAR; PG8_WAIT_L(0); PG8_MMA(0, 1, At, B1); PG8_BAR;
            PG8_LDA(At, 0, 1); PG8_STAGE(PG8_SA(0, 0), a2, voffA);
            PG8_BAR; PG8_WAIT_L(0); PG8_MMA(1, 0, At, B0); PG8_BAR; PG8_SCHED;
            PG8_STAGE(PG8_SB(0, 1), b2 + hstep, voffB);
            PG8_WAIT_V(6); PG8_BAR; PG8_MMA(1, 1, At, B1); PG8_BAR;
            PG8_LDB(B0, 1, 0); PG8_SCHED; PG8_LDA(At, 1, 0); PG8_STAGE(PG8_SA(0, 1), a2 + hstep, voffA);
            PG8_WAIT_L(8); PG8_BAR; PG8_WAIT_L(0); PG8_MMA(0, 0, At, B0); PG8_BAR; PG8_SCHED;
            PG8_LDB(B1, 1, 1); PG8_STAGE(PG8_SB(1, 0), b3, voffB);
            PG8_BAR; PG8_WAIT_L(0); PG8_MMA(0, 1, At, B1); PG8_BAR;
            PG8_LDA(At, 1, 1); PG8_STAGE(PG8_SA(1, 0), a3, voffA);
            PG8_BAR; PG8_WAIT_L(0); PG8_MMA(1, 0, At, B0); PG8_BAR; PG8_SCHED;
            PG8_STAGE(PG8_SB(1, 1), b3 + hstep, voffB);
            PG8_WAIT_V(6); PG8_BAR; PG8_MMA(1, 1, At, B1); PG8_BAR;
            }
        }
        if constexpr (ALIGN_EPI) { if (wr == 0) PG8_BAR; }
        if constexpr (!Epi::AFTER_DRAIN) { E(acc, cur, wr, wc, fr, fq); S.done(cur); }
        if (!has_next) break;
        if (!Epi::keep_acc(cur)) {
#pragma unroll
        for (int a = 0; a < 2; ++a)
#pragma unroll
            for (int b = 0; b < 2; ++b)
#pragma unroll
                for (int m = 0; m < 4; ++m)
#pragma unroll
                    for (int n = 0; n < 2; ++n) acc[a][b][m][n] = (f32x4){0.f, 0.f, 0.f, 0.f};
        }
        cur = nxt; cA = nA; cB = nB; ++ui;
        if constexpr (ALIGN_EPI) { if (wr == 1) PG8_BAR; }
    }
    PG8_WAIT_V(0);
    if constexpr (!ALIGN_EPI) { if (wr == 0) PG8_BAR; }
    PG8_BAR;
    if constexpr (Epi::AFTER_DRAIN) { E.fused(acc, cur, wr, wc, fr, fq, lds, wid, lane); S.done(cur); }
#undef PG8_SA
#undef PG8_SB
#undef PG8_STAGE
#undef PG8_LDA
#undef PG8_LDB
#undef PG8_MMA
#undef PG8_WAIT_V
#undef PG8_WAIT_L
#undef PG8_BAR
#undef PG8_SCHED
}
}

namespace att {
#define SBAR() __builtin_amdgcn_sched_barrier(0)
constexpr int LDK = 1024;
constexpr int KVBLK = 64;
constexpr float SCALE = 0.125f;
constexpr float THR = 8.f;
constexpr int SHM_T = KVBLK * 128 * 2;
constexpr int LDS_V = 0, LDS_K = 2 * SHM_T, LDS_WS = 4 * SHM_T, LDS_OX = 0;
#define KSWZ(row, colB) ((row) * 256 + ((colB) ^ (((row) & 7) << 4)))
#define KSWZ64(row, colB) ((row) * 128 + ((colB) ^ (((row) & 7) << 4)))
__device__ __forceinline__ int crow(int r, int hi) { return (r & 3) + 8 * (r >> 2) + 4 * hi; }

__device__ __forceinline__ void partialSM(f32x16& p0, f32x16& p1, float& m_reg, float& mn, float& alpha) {
  constexpr float C = SCALE * 1.4426950408889634f;
  float pmax = p0[0];
#pragma unroll
  for (int r = 1; r < 16; ++r) pmax = fmaxf(pmax, p0[r]);
#pragma unroll
  for (int r = 0; r < 16; ++r) pmax = fmaxf(pmax, p1[r]);
  { auto rr = __builtin_amdgcn_permlane32_swap(__float_as_uint(pmax), __float_as_uint(pmax), false, false);
    pmax = fmaxf(__uint_as_float(rr[0]), __uint_as_float(rr[1])); }
  if (__builtin_expect(__all(pmax - m_reg <= THR / SCALE), 1)) { mn = m_reg; alpha = 1.f; }
  else { mn = fmaxf(m_reg, pmax); alpha = __builtin_amdgcn_exp2f((m_reg - mn) * C); m_reg = mn; }
  float mnC = -mn * C;
#pragma unroll
  for (int r = 0; r < 16; ++r) p0[r] = fmaf(p0[r], C, mnC);
#pragma unroll
  for (int r = 0; r < 16; ++r) p1[r] = fmaf(p1[r], C, mnC);
#pragma unroll
  for (int r = 0; r < 16; ++r) p0[r] = __builtin_amdgcn_exp2f(p0[r]);
}
#define PK4(P, BASE, OUT) do { unsigned a0 = cvt_pk_bf16(P[BASE + 0], P[BASE + 1]), a1 = cvt_pk_bf16(P[BASE + 2], P[BASE + 3]);   \
    unsigned b0 = cvt_pk_bf16(P[BASE + 4], P[BASE + 5]), b1 = cvt_pk_bf16(P[BASE + 6], P[BASE + 7]);                              \
    auto r0 = __builtin_amdgcn_permlane32_swap(a0, b0, false, false); auto r1 = __builtin_amdgcn_permlane32_swap(a1, b1, false, false); \
    u32x4 w = {r0[0], r1[0], r0[1], r1[1]}; OUT = __builtin_bit_cast(bf16x8, w); } while (0)
__device__ __forceinline__ void packP(const f32x16& p0, const f32x16& p1, bf16x8& pa0, bf16x8& pa1, bf16x8& pa2, bf16x8& pa3) {
  PK4(p0, 0, pa0); PK4(p0, 8, pa1); PK4(p1, 0, pa2); PK4(p1, 8, pa3);
}
__device__ __forceinline__ void finishSM(f32x16& p0, f32x16& p1, float alpha, float& l_reg, bf16x8& pa0, bf16x8& pa1, bf16x8& pa2, bf16x8& pa3) {
#pragma unroll
  for (int r = 0; r < 16; ++r) p1[r] = __builtin_amdgcn_exp2f(p1[r]);
  float ps = 0;
#pragma unroll
  for (int r = 0; r < 16; ++r) ps += p0[r];
#pragma unroll
  for (int r = 0; r < 16; ++r) ps += p1[r];
  { auto rr = __builtin_amdgcn_permlane32_swap(__float_as_uint(ps), __float_as_uint(ps), false, false);
    ps = __uint_as_float(rr[0]) + __uint_as_float(rr[1]); }
  l_reg = l_reg * alpha + ps;
  packP(p0, p1, pa0, pa1, pa2, pa3);
}
__device__ __forceinline__ void qkt(f32x16& p0, f32x16& p1, const char* Ks, const bf16x8* qr, int r32, int hi, int cb0) {
  p0 = f32x16{}; p1 = f32x16{};
#pragma unroll
  for (int d0 = 0; d0 < 4; ++d0) { int cb = cb0 + (d0 * 16 + hi * 8) * 2;
    bf16x8 b0 = *reinterpret_cast<const bf16x8*>(Ks + KSWZ(r32, cb));
    bf16x8 b1 = *reinterpret_cast<const bf16x8*>(Ks + KSWZ(32 + r32, cb));
    p0 = __builtin_amdgcn_mfma_f32_32x32x16_bf16(b0, qr[d0], p0, 0, 0, 0);
    p1 = __builtin_amdgcn_mfma_f32_32x32x16_bf16(b1, qr[d0], p1, 0, 0, 0); }
}
__device__ __forceinline__ int v_st(int k, int c) { const int kk = (k & ~0xC) | ((k & 4) << 1) | ((k & 8) >> 1); return ((kk >> 3) * 4 + (c >> 5)) * 512 + ((kk & 7) * 32 + (c & 31)) * 2; }
__device__ __forceinline__ int v_rd_base(int lane) { return ((lane & 3) << 3) | (((lane >> 2) & 3) << 6) | (((lane >> 4) & 1) << 5) | (((lane >> 5) & 1) << 8); }
template <int OFF> __device__ __forceinline__ s16x4 tr_read(int vb) {
  s16x4 r; asm volatile("ds_read_b64_tr_b16 %0, %1 offset:%2" : "=&v"(r) : "v"(vb), "i"(OFF) : "memory"); return r;
}
#define PKF(L, H) (bf16x8){L[0], L[1], L[2], L[3], H[0], H[1], H[2], H[3]}
__device__ __forceinline__ void pv_blk(f32x16& od, int vb, bf16x8 pa0, bf16x8 pa1, bf16x8 pa2, bf16x8 pa3) {
  const s16x4 l0 = tr_read<0>(vb), h0 = tr_read<2048>(vb), l1 = tr_read<4096>(vb), h1 = tr_read<4096 + 2048>(vb);
  const s16x4 l2 = tr_read<8192>(vb), h2 = tr_read<8192 + 2048>(vb), l3 = tr_read<12288>(vb), h3 = tr_read<12288 + 2048>(vb);
  asm volatile("s_waitcnt lgkmcnt(0)" ::: "memory"); SBAR();
  od = __builtin_amdgcn_mfma_f32_32x32x16_bf16(pa0, PKF(l0, h0), od, 0, 0, 0);
  od = __builtin_amdgcn_mfma_f32_32x32x16_bf16(pa1, PKF(l1, h1), od, 0, 0, 0);
  od = __builtin_amdgcn_mfma_f32_32x32x16_bf16(pa2, PKF(l2, h2), od, 0, 0, 0);
  od = __builtin_amdgcn_mfma_f32_32x32x16_bf16(pa3, PKF(l3, h3), od, 0, 0, 0);
}
__device__ __forceinline__ void pv_d0(f32x16* o, int vb, bf16x8 pa0, bf16x8 pa1, bf16x8 pa2, bf16x8 pa3) {
  pv_blk(o[0], vb, pa0, pa1, pa2, pa3); pv_blk(o[1], vb + 512, pa0, pa1, pa2, pa3); pv_blk(o[2], vb + 1024, pa0, pa1, pa2, pa3); pv_blk(o[3], vb + 1536, pa0, pa1, pa2, pa3);
}
__device__ __forceinline__ void tr_frag4(bf16x8* f, int vb) {
  const s16x4 l0 = tr_read<0>(vb), h0 = tr_read<2048>(vb), l1 = tr_read<4096>(vb), h1 = tr_read<4096 + 2048>(vb);
  const s16x4 l2 = tr_read<8192>(vb), h2 = tr_read<8192 + 2048>(vb), l3 = tr_read<12288>(vb), h3 = tr_read<12288 + 2048>(vb);
  asm volatile("s_waitcnt lgkmcnt(0)" ::: "memory"); SBAR();
  f[0] = PKF(l0, h0); f[1] = PKF(l1, h1); f[2] = PKF(l2, h2); f[3] = PKF(l3, h3);
}

template <int MODE>
__device__ __forceinline__ void combine_store(f32x16 (&o)[4], float lam, const float* gain, const bf16_t* zb, bf16_t* ob, char* lds) {
  int tidx = threadIdx.x; asm volatile("" : "+v"(tidx));
  const int wid = __builtin_amdgcn_readfirstlane(tidx >> 6), half = wid >> 2, w4 = wid & 3, r32 = tidx & 31, hi = (tidx >> 5) & 1;
  float* Ox = (float*)(lds + LDS_OX);
  u32x4 zv[4];
#pragma unroll
  for (int i = 0; i < 4; ++i) { const int id = tidx + 512 * i; zv[i] = *(const u32x4*)(zb + (size_t)(id >> 4) * LDK + (id & 15) * 8); }
  __syncthreads();
  if (half == 1) {
#pragma unroll
    for (int r = 0; r < 16; ++r) { const int row = w4 * 32 + crow(r, hi);
#pragma unroll
      for (int d0 = 0; d0 < 4; ++d0) Ox[row * 128 + d0 * 32 + r32] = o[d0][r]; }
  }
  __syncthreads();
  if (half == 0) {
    float gn[4];
#pragma unroll
    for (int d0 = 0; d0 < 4; ++d0) gn[d0] = gain[d0 * 32 + r32] * (MODE == 0 ? (1.f - LAM_INIT) : 1.f);
#pragma unroll
    for (int r = 0; r < 16; ++r) { const int row = w4 * 32 + crow(r, hi);
      float s1 = 0.f, s2 = 0.f; float v[4];
#pragma unroll
      for (int d0 = 0; d0 < 4; ++d0) { const float x = Ox[row * 128 + d0 * 32 + r32]; v[d0] = (MODE == 0) ? (o[d0][r] - lam * x) : (o[d0][r] + x); s1 += v[d0]; s2 += v[d0] * v[d0]; }
#pragma unroll
      for (int sh = 1; sh < 32; sh <<= 1) { s1 += __shfl_xor(s1, sh); s2 += __shfl_xor(s2, sh); }
      float mean, rstd;
      if (MODE == 0) { mean = 0.f; rstd = 1.0f / sqrtf(s2 * (1.f / 128.f) + LN_EPS); }
      else { mean = s1 * (1.f / 128.f); float var = s2 * (1.f / 128.f) - mean * mean; var = var < 0.f ? 0.f : var; rstd = 1.0f / sqrtf(var + LN_EPS); }
#pragma unroll
      for (int d0 = 0; d0 < 4; ++d0) Ox[row * 128 + d0 * 32 + r32] = (v[d0] - mean) * rstd * gn[d0];
    }
  }
  __syncthreads();
#pragma unroll
  for (int i = 0; i < 4; ++i) { const int id = tidx + 512 * i, row = id >> 4, q = id & 15;
    const f32x4 a = *(const f32x4*)(Ox + row * 128 + q * 8), b = *(const f32x4*)(Ox + row * 128 + q * 8 + 4);
    u32x4 w; w.x = cvt_pk_bf16(a[0] * bf_lo(zv[i].x), a[1] * bf_hi(zv[i].x)); w.y = cvt_pk_bf16(a[2] * bf_lo(zv[i].y), a[3] * bf_hi(zv[i].y));
    w.z = cvt_pk_bf16(b[0] * bf_lo(zv[i].z), b[1] * bf_hi(zv[i].z)); w.w = cvt_pk_bf16(b[2] * bf_lo(zv[i].w), b[3] * bf_hi(zv[i].w));
    *(u32x4*)(ob + (size_t)row * LDK + q * 8) = w; }
  __syncthreads();
}

__device__ __forceinline__ void attn_unit(const bf16_t* Qb, const bf16_t* Kh, const bf16_t* Vh, int seq, float lam, const float* subg, const bf16_t* zb, bf16_t* ob, char* lds) {
  const int tid = threadIdx.x, wid = __builtin_amdgcn_readfirstlane(tid >> 6), lane = tid & 63, r32 = lane & 31, hi = lane >> 5, map = wid >> 2, w4 = wid & 3;
  char* V_lds = lds + LDS_V; char* K_lds = lds + LDS_K;
  float* ws = (float*)(lds + LDS_WS) + wid * 64; float* li_l = ws; float* al_l = ws + 32;
  float m_reg = -1e30f, l_reg = 0; f32x16 o[4] = {}; bf16x8 qr[4];
  const bf16_t* Qw = Qb + (size_t)(w4 * 32 + r32) * LDK + map * 64 + hi * 8;
#pragma unroll
  for (int d0 = 0; d0 < 4; ++d0) qr[d0] = *reinterpret_cast<const bf16x8*>(Qw + d0 * 16);
  const int cb0 = map * 128;
  const int sr = tid >> 4, sc = (tid & 15) * 8, vst0 = v_st(sr, sc), vst1 = v_st(32 + sr, sc);
  const int vb0 = (int)(uintptr_t)V_lds + v_rd_base(lane);
  struct { bf16x8 vs0, vs1, ks0, ks1; } sr_[2];
#define SLOAD(i, k0) do { sr_[i].vs0 = *(const bf16x8*)(&Vh[(size_t)((k0) + sr) * LDK + sc]); sr_[i].vs1 = *(const bf16x8*)(&Vh[(size_t)((k0) + 32 + sr) * LDK + sc]); \
    sr_[i].ks0 = *(const bf16x8*)(&Kh[(size_t)((k0) + sr) * LDK + sc]); sr_[i].ks1 = *(const bf16x8*)(&Kh[(size_t)((k0) + 32 + sr) * LDK + sc]); } while (0)
#define SWRITE(b, i) do { *(bf16x8*)(V_lds + (b) * SHM_T + vst0) = sr_[i].vs0;          \
    *(bf16x8*)(V_lds + (b) * SHM_T + vst1) = sr_[i].vs1; int kc = sc * 2;               \
    *(bf16x8*)(K_lds + (b) * SHM_T + KSWZ(sr, kc)) = sr_[i].ks0;                       \
    *(bf16x8*)(K_lds + (b) * SHM_T + KSWZ(32 + sr, kc)) = sr_[i].ks1; } while (0)
#define SWAIT() asm volatile("s_waitcnt vmcnt(4)" ::: "memory")
#define RESC(a) do { if (__any((a) < 1.f)) { if (hi == 0) al_l[r32] = (a); asm volatile("s_waitcnt lgkmcnt(0)" ::: "memory"); \
    _Pragma("unroll") for (int d = 0; d < 4; ++d) _Pragma("unroll") for (int r = 0; r < 16; ++r) o[d][r] *= al_l[crow(r, hi)]; } } while (0)
  f32x16 pA0, pA1, pB0, pB1; float mnA, mnB, alA, alB; bf16x8 pa0, pa1, pa2, pa3; const int NT = seq / KVBLK;
  constexpr int SE = 0, SO = 1;
  SLOAD(SE, 0); asm volatile("s_waitcnt vmcnt(0)" ::: "memory"); SWRITE(0, SE); __syncthreads();
  qkt(pA0, pA1, K_lds, qr, r32, hi, cb0); partialSM(pA0, pA1, m_reg, mnA, alA);
  SLOAD(SO, KVBLK); if (2 < NT) SLOAD(SE, 2 * KVBLK);
  SWAIT(); SWRITE(1, SO); __syncthreads();
  for (int j = 1; j + 1 < NT; j += 2) {
    SBAR(); qkt(pB0, pB1, K_lds + SHM_T, qr, r32, hi, cb0);
    finishSM(pA0, pA1, alA, l_reg, pa0, pa1, pa2, pa3); SBAR();
    SLOAD(SO, (j + 2) * KVBLK); SBAR();
    pv_d0(o, vb0, pa0, pa1, pa2, pa3); partialSM(pB0, pB1, m_reg, mnB, alB);
    __syncthreads(); SWAIT(); SWRITE(0, SE);
    RESC(alB); __syncthreads();
    SBAR(); qkt(pA0, pA1, K_lds, qr, r32, hi, cb0);
    finishSM(pB0, pB1, alB, l_reg, pa0, pa1, pa2, pa3); SBAR();
    if (j + 3 < NT) SLOAD(SE, (j + 3) * KVBLK); SBAR();
    pv_d0(o, vb0 + SHM_T, pa0, pa1, pa2, pa3); partialSM(pA0, pA1, m_reg, mnA, alA);
    __syncthreads(); SWAIT(); SWRITE(1, SO);
    RESC(alA); __syncthreads();
  }
  SBAR(); qkt(pB0, pB1, K_lds + SHM_T, qr, r32, hi, cb0);
  finishSM(pA0, pA1, alA, l_reg, pa0, pa1, pa2, pa3); SBAR();
  pv_d0(o, vb0, pa0, pa1, pa2, pa3); partialSM(pB0, pB1, m_reg, mnB, alB);
  __syncthreads(); RESC(alB);
  finishSM(pB0, pB1, alB, l_reg, pa0, pa1, pa2, pa3); SBAR();
  pv_d0(o, vb0 + SHM_T, pa0, pa1, pa2, pa3);
  if (hi == 0) li_l[r32] = l_reg; asm volatile("s_waitcnt lgkmcnt(0)" ::: "memory");
#pragma unroll
  for (int r = 0; r < 16; ++r) { const float rl = __builtin_amdgcn_rcpf(li_l[crow(r, hi)]);
#pragma unroll
    for (int d0 = 0; d0 < 4; ++d0) o[d0][r] *= rl; }
  combine_store<0>(o, lam, subg, zb, ob, lds);
#undef SLOAD
#undef SWRITE
#undef SWAIT
#undef RESC
}

__device__ __forceinline__ bf16x8 scale8(bf16x8 x, float s) {
  const u32x4 w = __builtin_bit_cast(u32x4, x); u32x4 o;
  o.x = cvt_pk_bf16(bf_lo(w.x) * s, bf_hi(w.x) * s); o.y = cvt_pk_bf16(bf_lo(w.y) * s, bf_hi(w.y) * s);
  o.z = cvt_pk_bf16(bf_lo(w.z) * s, bf_hi(w.z) * s); o.w = cvt_pk_bf16(bf_lo(w.w) * s, bf_hi(w.w) * s);
  return __builtin_bit_cast(bf16x8, o);
}

__device__ __forceinline__ void ret_local_unit(const bf16_t* Kp, const bf16_t* Vp, float l2f, float l2b, float* Lout, char* lds) {
  const int tid = threadIdx.x, wid = __builtin_amdgcn_readfirstlane(tid >> 6), lane = tid & 63, r32 = lane & 31, hi = lane >> 5;
  char* Kimg = lds; char* Vimg = lds + 2 * SHM_T;
  const int sr = tid >> 4, sc = (tid & 15) * 8, dir = sc >> 6, kc = sc & 63;
  bf16x8 vv[4], kk[4];
#pragma unroll
  for (int q = 0; q < 4; ++q) { const int j = 64 * (q >> 1) + sr + 32 * (q & 1);
    vv[q] = *(const bf16x8*)(Vp + (size_t)j * 1024 + sc); kk[q] = *(const bf16x8*)(Kp + (size_t)j * 512 + kc); }
#pragma unroll
  for (int q = 0; q < 4; ++q) { const int t = q >> 1, row = sr + 32 * (q & 1), j = 64 * t + row;
    const float dec = dir == 0 ? __builtin_amdgcn_exp2f(l2f * (float)(127 - j)) : __builtin_amdgcn_exp2f(l2b * (float)j);
    *(bf16x8*)(Vimg + t * SHM_T + v_st(row, sc)) = vv[q];
    *(bf16x8*)(Kimg + t * SHM_T + v_st(row, sc)) = scale8(kk[q], dec); }
  __syncthreads();
  const int ra = wid >> 1, cb = (wid & 1) * 2;
  const int vrd = v_rd_base(lane);
  f32x16 acc0 = {}, acc1 = {};
#pragma unroll
  for (int t = 0; t < 2; ++t) {
    bf16x8 af[4]; tr_frag4(af, (int)(uintptr_t)(Kimg + t * SHM_T) + vrd + 512 * ra);
    pv_blk(acc0, (int)(uintptr_t)(Vimg + t * SHM_T) + vrd + 512 * cb, af[0], af[1], af[2], af[3]);
    pv_blk(acc1, (int)(uintptr_t)(Vimg + t * SHM_T) + vrd + 512 * (cb + 1), af[0], af[1], af[2], af[3]);
  }
  float* Lo = Lout + (size_t)((ra >> 1) * 64 + 32 * (ra & 1)) * 128 + 32 * cb + r32;
#pragma unroll
  for (int r = 0; r < 16; ++r) { Lo[crow(r, hi) * 128] = acc0[r]; Lo[crow(r, hi) * 128 + 32] = acc1[r]; }
  __syncthreads();
}

__device__ __forceinline__ void ret_out_unit(const bf16_t* Qp, const bf16_t* Kp, const bf16_t* Vp, const bf16_t* Pf, const bf16_t* Pb, float l2f, float l2b,
                                             const float* gain, const bf16_t* zb, bf16_t* ob, char* lds) {
  const int tid = threadIdx.x, wid = __builtin_amdgcn_readfirstlane(tid >> 6), lane = tid & 63, r32 = lane & 31, hi = lane >> 5, qblk = wid & 3, kt = wid >> 2;
  char* Kimg = lds; char* Vimg = lds + SHM_T; char* Pimg = lds + 3 * SHM_T;
  const int i = 32 * qblk + r32;
  bf16x8 qr[4];
  { const int row = tid >> 3, c8 = (tid & 7) * 8, sr = tid >> 4, sc = (tid & 15) * 8;
    bf16x8 kk[2], vv[4], pp[4];
#pragma unroll
    for (int rr = 0; rr < 2; ++rr) kk[rr] = *(const bf16x8*)(Kp + (size_t)(row + 64 * rr) * 512 + c8);
#pragma unroll
    for (int q = 0; q < 4; ++q) { const int t = q >> 1, rw = sr + 32 * (q & 1);
      vv[q] = *(const bf16x8*)(Vp + (size_t)(64 * t + rw) * 1024 + sc); pp[q] = *(const bf16x8*)((t == 0 ? Pf : Pb) + rw * 128 + sc); }
#pragma unroll
    for (int d0 = 0; d0 < 4; ++d0) qr[d0] = *(const bf16x8*)(Qp + (size_t)i * 512 + d0 * 16 + hi * 8);
#pragma unroll
    for (int rr = 0; rr < 2; ++rr) *(bf16x8*)(Kimg + KSWZ64(row + 64 * rr, c8 * 2)) = kk[rr];
#pragma unroll
    for (int q = 0; q < 4; ++q) { const int t = q >> 1, rw = sr + 32 * (q & 1);
      *(bf16x8*)(Vimg + t * SHM_T + v_st(rw, sc)) = vv[q]; *(bf16x8*)(Pimg + t * SHM_T + v_st(rw, sc)) = pp[q]; } }
  __syncthreads();
  f32x16 p0 = {}, p1 = {};
#pragma unroll
  for (int d0 = 0; d0 < 4; ++d0) { const int cb = (d0 * 16 + hi * 8) * 2;
    const bf16x8 b0 = *(const bf16x8*)(Kimg + KSWZ64(64 * kt + r32, cb));
    const bf16x8 b1 = *(const bf16x8*)(Kimg + KSWZ64(64 * kt + 32 + r32, cb));
    p0 = __builtin_amdgcn_mfma_f32_32x32x16_bf16(b0, qr[d0], p0, 0, 0, 0);
    p1 = __builtin_amdgcn_mfma_f32_32x32x16_bf16(b1, qr[d0], p1, 0, 0, 0); }
#pragma unroll
  for (int r = 0; r < 16; ++r) { const int j0 = 64 * kt + crow(r, hi); const int d0 = i - j0, d1 = d0 - 32;
    const float w0 = d0 > 0 ? __builtin_amdgcn_exp2f(l2f * (float)d0) : (d0 < 0 ? __builtin_amdgcn_exp2f(l2b * (float)(-d0)) : 2.f);
    const float w1 = d1 > 0 ? __builtin_amdgcn_exp2f(l2f * (float)d1) : (d1 < 0 ? __builtin_amdgcn_exp2f(l2b * (float)(-d1)) : 2.f);
    p0[r] *= w0; p1[r] *= w1; }
  bf16x8 pa0, pa1, pa2, pa3; packP(p0, p1, pa0, pa1, pa2, pa3);
  f32x16 o[4] = {};
  const int vrd = v_rd_base(lane);
  pv_d0(o, (int)(uintptr_t)(Vimg + kt * SHM_T) + vrd, pa0, pa1, pa2, pa3);
  const float qs = kt == 0 ? __builtin_amdgcn_exp2f(l2f * (float)(i + 1)) : __builtin_amdgcn_exp2f(l2b * (float)(128 - i));
  pv_d0(o, (int)(uintptr_t)(Pimg + kt * SHM_T) + vrd, scale8(qr[0], qs), scale8(qr[1], qs), scale8(qr[2], qs), scale8(qr[3], qs));
  combine_store<1>(o, 0.f, gain, zb, ob, lds);
}
#undef SBAR
}
typedef GAS unsigned gu32;
typedef GAS unsigned long long gu64;
#define RLX_AGENT __ATOMIC_RELAXED, __HIP_MEMORY_SCOPE_AGENT
#define LDS_WAIT() asm volatile("s_waitcnt lgkmcnt(0)" ::: "memory")
#define VM_WAIT() asm volatile("s_waitcnt vmcnt(0)" ::: "memory")

#define XB_TMO      128
#define XB_XCNT(j)  (256  + 64 * (j))
#define XB_XSUB(j)  (1280 + 64 * (j))
#define XB_XGEN(j)  (2304 + 64 * (j))
#define XB_TOP      3328
#define XB_TOPGEN   3392
#define XCD_BAR_WORDS 3456
#define XB_SPIN_CAP (1u << 18)

__device__ __forceinline__ unsigned xb_ld(unsigned* p)              { return __hip_atomic_load(p, __ATOMIC_RELAXED, __HIP_MEMORY_SCOPE_AGENT); }
__device__ __forceinline__ unsigned xb_add(unsigned* p, unsigned v) { return __hip_atomic_fetch_add(p, v, __ATOMIC_RELAXED, __HIP_MEMORY_SCOPE_AGENT); }
__device__ __forceinline__ unsigned xb_xcc_id() { return (unsigned)__builtin_amdgcn_s_getreg((3 << 11) | 20) & 0xFu; }
#define XB_SPIN(cond, bar) do { unsigned _sp = 0; while (cond) { __builtin_amdgcn_s_sleep(1); \
    if ((++_sp & 255u) == 0u) { if (xb_ld(&(bar)[XB_TMO])) break; if (_sp > XB_SPIN_CAP) { atomicAdd(&(bar)[XB_TMO], 1u); break; } } } } while (0)

struct XcdBarrier {
    unsigned* bar; unsigned x;
    volatile LAS unsigned* st;
};

__device__ __forceinline__ XcdBarrier xcd_barrier_post(unsigned* bar, volatile LAS unsigned* st) {
    XcdBarrier b; b.bar = bar; b.x = xb_xcc_id(); b.st = st;
    if (threadIdx.x == 0) (void)xb_add(&bar[XB_XCNT(b.x)], 1u);
    return b;
}
__device__ __forceinline__ void xcd_barrier_complete(unsigned* bar, unsigned x, unsigned& nloc, unsigned& nx) {
    const unsigned G = gridDim.x * gridDim.y * gridDim.z;
    unsigned sum, cnt, mine, sp = 0u;
    for (;;) {
        sum = 0u; cnt = 0u; mine = 0u;
#pragma unroll
        for (unsigned j = 0; j < 16; ++j) { const unsigned c = xb_ld(&bar[XB_XCNT(j)]); sum += c; cnt += (c > 0u) ? 1u : 0u; mine = (j == x) ? c : mine; }
        if (sum == G) break;
        __builtin_amdgcn_s_sleep(1);
        if ((++sp & 255u) == 0u) { if (xb_ld(&bar[XB_TMO])) break; if (sp > XB_SPIN_CAP) { atomicAdd(&bar[XB_TMO], 1u); break; } }
    }
    nloc = mine > 0u ? mine : 1u; nx = cnt > 0u ? cnt : 1u;
}

__device__ __forceinline__ void xcd_barrier(const XcdBarrier& b) {
    asm volatile("s_waitcnt vmcnt(0)" ::: "memory");
    __syncthreads();
    if (threadIdx.x == 0) {
        unsigned* bar = b.bar;
        __builtin_amdgcn_s_waitcnt(0);
        unsigned nloc = b.st[0], nx = b.st[1];
        if (nloc == 0u) { xcd_barrier_complete(bar, b.x, nloc, nx); b.st[0] = nloc; b.st[1] = nx; }
        const unsigned old = xb_add(&bar[XB_XSUB(b.x)], 1u);
        const unsigned gen = old / nloc;
        if (old + 1u == (gen + 1u) * nloc) {
            __builtin_amdgcn_fence(__ATOMIC_RELEASE, "agent");
            asm volatile("s_waitcnt vmcnt(0)" ::: "memory");
            const unsigned og = xb_add(&bar[XB_TOP], 1u);
            const unsigned tg = og / nx;
            if (og + 1u == (tg + 1u) * nx) xb_add(&bar[XB_TOPGEN], 1u);
            else XB_SPIN(xb_ld(&bar[XB_TOPGEN]) == tg, bar);
            __builtin_amdgcn_fence(__ATOMIC_ACQUIRE, "agent");
            xb_add(&bar[XB_XGEN(b.x)], 1u);
            asm volatile("s_waitcnt vmcnt(0)" ::: "memory");
        } else {
            XB_SPIN(xb_ld(&bar[XB_XGEN(b.x)]) == gen, bar);
            __builtin_amdgcn_fence(__ATOMIC_ACQUIRE, "agent");
            asm volatile("s_waitcnt vmcnt(0)" ::: "memory");
        }
    }
    __syncthreads();
}

#ifndef MK_N_LAUNCHES
#define MK_N_LAUNCHES 1
#endif
#ifndef REP_P0A
#define REP_P0A 1
#endif
#ifndef REP_P0B
#define REP_P0B 1
#endif
#ifndef REP_P1
#define REP_P1 1
#endif
#ifndef REP_P2A
#define REP_P2A 1
#endif
#ifndef REP_P2B
#define REP_P2B 1
#endif
#ifndef REP_P3
#define REP_P3 1
#endif
#ifndef REP_P4
#define REP_P4 1
#endif
#ifndef REP_P5
#define REP_P5 1
#endif
#ifndef REP_P6
#define REP_P6 1
#endif
#ifndef REP_P7
#define REP_P7 1
#endif
#define REPEAT(n) for (int rep_ = 0; rep_ < (n); ++rep_)
constexpr int N_PHASES = 9;
constexpr int NWAVES = 8;
constexpr size_t MiB = 1u << 20;
constexpr size_t WS_CTL = 0, CTL_ZERO_BYTES = 64 * 1024;
constexpr size_t WS_WCAT = 2 * MiB;
constexpr size_t WS_WPA = 20 * MiB, WS_WPR = 22 * MiB, WS_WOUT = 24 * MiB;
constexpr size_t WS_QA = 26 * MiB;
constexpr size_t WS_ZA = 50 * MiB;
constexpr size_t WS_QR = 74 * MiB, WS_KR = 86 * MiB;
constexpr size_t WS_VR = 98 * MiB;
constexpr size_t WS_ZR = 122 * MiB;
constexpr size_t WS_G = 146 * MiB;
constexpr size_t WS_KC = 194 * MiB, WS_VC = 202 * MiB;
constexpr size_t WS_KL = 210 * MiB, WS_VL = 228 * MiB;
constexpr size_t WS_PST = 194 * MiB;
constexpr size_t WS_MODP = 246 * MiB;
constexpr size_t WS_MODF = 247 * MiB;
constexpr size_t WS_ROPE = 247 * MiB + 64 * 1024;
constexpr size_t WS_MISC = 247 * MiB + 128 * 1024;
constexpr size_t WS_STATS = 248 * MiB;
constexpr size_t WS_END = 249 * MiB;
static_assert(WS_WCAT + (size_t)N_CAT * DM * 2 <= WS_WPA && WS_VL + (size_t)LAT_B * LAT_KEYS * 1024 * 2 <= WS_MODP && WS_PST + (size_t)768 * 2 * 8192 * 2 <= WS_MODP, "d_ws map");
constexpr size_t OUT_Y = 0, OUT_K = 12582912, OUT_V = 16777216, OUT_SF = 20971520, OUT_SB = 22020096, OUT_END = 23068672;
constexpr int CW_BAR = 1024;
constexpr int RING_BYTES = 131072, LDSCTL_OFF = RING_BYTES, MISC_OFF = LDSCTL_OFF + 320, LDS_BYTES = 147456;

__device__ __forceinline__ float wave_sum(float v) {
#pragma unroll
    for (int o = 1; o < 64; o <<= 1) v += __shfl_xor(v, o);
    return v;
}
__device__ __forceinline__ void p0_transpose_item(const float* W, int K, int N, bf16_t* WT, int row_off, LAS float* scr, int item, int lane) {
    const int nblk = N / 32, kb = item / nblk, nb = item % nblk, k0 = 64 * kb, n0 = 32 * nb;
#pragma unroll 8
    for (int i = 0; i < 32; ++i) { const int kk = 2 * i + (lane >> 5); scr[kk * 33 + (lane & 31)] = W[(size_t)(k0 + kk) * N + n0 + (lane & 31)]; }
    LDS_WAIT(); asm volatile("" ::: "memory");
    const int c = lane & 7;
#pragma unroll
    for (int j = 0; j < 4; ++j) { const int n = (lane >> 3) + 8 * j; const LAS float* s = scr + (8 * c) * 33 + n;
        u32x4 o; o.x = cvt_pk_bf16(s[0 * 33], s[1 * 33]); o.y = cvt_pk_bf16(s[2 * 33], s[3 * 33]); o.z = cvt_pk_bf16(s[4 * 33], s[5 * 33]); o.w = cvt_pk_bf16(s[6 * 33], s[7 * 33]);
        *(u32x4*)(WT + (size_t)(row_off + n0 + n) * K + k0 + 8 * c) = o; }
    LDS_WAIT(); asm volatile("" ::: "memory");
}
__device__ __forceinline__ void sincos_d(double a, double& s, double& c) {
    const double TWO_PI = 6.283185307179586476925286766559;
    const double n = __builtin_rint(a / TWO_PI); const double x = a - n * TWO_PI, x2 = x * x;
    double ts = 1.0, tc = 1.0, ss = 1.0, cc = 1.0;
#pragma unroll
    for (int k = 1; k <= 14; ++k) { tc *= -x2 / (double)((2 * k - 1) * (2 * k)); ts *= -x2 / (double)((2 * k) * (2 * k + 1)); cc += tc; ss += ts; }
    s = x * ss; c = cc;
}
__device__ __forceinline__ float log2_gamma(float rd) { return log1pf(-exp2f(rd)) * 1.4426950408889634f; }

struct Args { const float* in[22]; float* out; unsigned char* ws; int ph_lo, ph_hi; };

__global__ void __launch_bounds__(NWAVES * 64, 2) mk_fwd(Args args) {
    extern __shared__ __attribute__((aligned(16))) unsigned char lds[];
    LAS unsigned char* ldsl = (LAS unsigned char*)lds;
    const int tid = threadIdx.x, lane = tid & 63, wave = __builtin_amdgcn_readfirstlane(tid >> 6);
    const int G = gridDim.x; const int bx = blockIdx.x; const int vcu = (G % 8 == 0) ? (bx % 8) * (G / 8) + bx / 8 : bx;
    unsigned char* ws = args.ws; float* dout = args.out;
    gu32* ctl = (gu32*)(ws + WS_CTL);
    volatile LAS unsigned* MISC = (volatile LAS unsigned*)(ldsl + MISC_OFF);
    for (int u = tid; u < (LDS_BYTES - LDSCTL_OFF) / 4; u += NWAVES * 64) ((LAS unsigned*)(ldsl + LDSCTL_OFF))[u] = 0u;
    __syncthreads();
    const int lo = args.ph_lo, hi = args.ph_hi;
    XcdBarrier bar; bar.bar = (unsigned*)(ctl + CW_BAR); bar.x = 0; bar.st = nullptr;
    if (hi - lo > 1) bar = xcd_barrier_post((unsigned*)(ctl + CW_BAR), MISC + 8);
#ifndef PHASE_MASK
#define PHASE_MASK 0x1ff
#endif
#define IN(k) (((PHASE_MASK >> (k)) & 1) && lo <= (k) && (k) < hi)
#define SEAM(k) do { if (IN(k) && IN((k) + 1)) xcd_barrier(bar); } while (0)
    const float* x_prompt = args.in[0]; const float* x_sample = args.in[1]; const float* cache_k = args.in[2]; const float* cache_v = args.in[3];
    const float* st_f = args.in[4]; const float* st_b = args.in[5]; const float* c_lat = args.in[6]; const float* c_ctx = args.in[7];
    const float* w_mod = args.in[8]; const float* b_mod = args.in[9]; const float* w_in = args.in[10]; const float* lam_p = args.in[11];
    const float* subln_g = args.in[12]; const float* ret_decay = args.in[13]; const float* ret_gn_g = args.in[14];
    const float* w_pa = args.in[15]; const float* w_pr = args.in[16]; const float* w_gate = args.in[17]; const float* b_gate = args.in[18];
    const float* w_out = args.in[19]; const float* ln_g = args.in[20]; const float* ln_b = args.in[21];
    bf16_t* WCAT = (bf16_t*)(ws + WS_WCAT); bf16_t* WPA = (bf16_t*)(ws + WS_WPA); bf16_t* WPR = (bf16_t*)(ws + WS_WPR); bf16_t* WOUT = (bf16_t*)(ws + WS_WOUT);
    bf16_t* QA = (bf16_t*)(ws + WS_QA); bf16_t* ZA = (bf16_t*)(ws + WS_ZA); bf16_t* QR = (bf16_t*)(ws + WS_QR); bf16_t* KR = (bf16_t*)(ws + WS_KR);
    bf16_t* VR = (bf16_t*)(ws + WS_VR); bf16_t* ZR = (bf16_t*)(ws + WS_ZR); bf16_t* GT = (bf16_t*)(ws + WS_G);
    bf16_t* KC = (bf16_t*)(ws + WS_KC); bf16_t* VC = (bf16_t*)(ws + WS_VC); bf16_t* KL = (bf16_t*)(ws + WS_KL); bf16_t* VL = (bf16_t*)(ws + WS_VL);
    bf16_t* PST = (bf16_t*)(ws + WS_PST);
    float* MODP = (float*)(ws + WS_MODP); float* MODF = (float*)(ws + WS_MODF); float* ROPE = (float*)(ws + WS_ROPE); float* MISCW = (float*)(ws + WS_MISC); float* STATS = (float*)(ws + WS_STATS);
    bf16_t* HB = (bf16_t*)dout;
    float* LST = dout;
    const int gw = vcu * NWAVES + wave, NGW = G * NWAVES;
    const int gt = bx * (NWAVES * 64) + tid, NGT = G * NWAVES * 64;

    if (IN(0)) REPEAT(REP_P0A) {
        LAS float* scr = (LAS float*)(ldsl + wave * 16384);
        constexpr int I_MOD = 192, I_IN = 16 * (N_IN / 32), I_GT = 16 * (N_GATE / 32), I_SQ = 16 * 32;
        constexpr int NITEMS = I_MOD + I_IN + I_GT + 3 * I_SQ;
        for (int it = gw; it < NITEMS; it += NGW) {
            int r = it;
            if (r < I_MOD) {
                const int cg = r % 12, ks = r / 12;
                float sv[5];
                { const int k = 64 * ks + lane; sv[0] = silu_f(c_ctx[k]);
#pragma unroll
                  for (int j = 1; j < 5; ++j) sv[j] = silu_f(c_lat[(j - 1) * DM + k]); }
                f32x4 a[5];
#pragma unroll
                for (int j = 0; j < 5; ++j) a[j] = (f32x4){0.f, 0.f, 0.f, 0.f};
                const float* wp = w_mod + (size_t)(64 * ks) * 3072 + 256 * cg + 4 * lane;
#pragma unroll 8
                for (int kk = 0; kk < 64; ++kk) { const f32x4 w = *(const f32x4*)(wp + (size_t)kk * 3072);
#pragma unroll
                    for (int j = 0; j < 5; ++j) a[j] += w * __shfl(sv[j], kk); }
#pragma unroll
                for (int j = 0; j < 5; ++j) *(f32x4*)(MODP + ((size_t)ks * 5 + j) * 3072 + 256 * cg + 4 * lane) = a[j];
                continue; }
            r -= I_MOD;
            if (r < I_IN) { p0_transpose_item(w_in, DM, N_IN, WCAT, 0, scr, r, lane); continue; } r -= I_IN;
            if (r < I_GT) { p0_transpose_item(w_gate, DM, N_GATE, WCAT, N_IN, scr, r, lane); continue; } r -= I_GT;
            if (r < I_SQ) { p0_transpose_item(w_pa, DM, DM, WPA, 0, scr, r, lane); continue; } r -= I_SQ;
            if (r < I_SQ) { p0_transpose_item(w_pr, DM, DM, WPR, 0, scr, r, lane); continue; } r -= I_SQ;
            p0_transpose_item(w_out, DM, DM, WOUT, 0, scr, r, lane);
        }
        for (int i = gt; i < 2 * LAT_B * PAST * 128; i += NGT) {
            const int which = i / (LAT_B * PAST * 128), j = i % (LAT_B * PAST * 128), b = j / (PAST * 128), e = (j % (PAST * 128)) * 8;
            const float* src = (which ? cache_v : cache_k) + (size_t)b * PAST * 1024 + e;
            const f32x4 a = *(const f32x4*)src, c = *(const f32x4*)(src + 4);
            u32x4 w; w.x = cvt_pk_bf16(a[0], a[1]); w.y = cvt_pk_bf16(a[2], a[3]); w.z = cvt_pk_bf16(c[0], c[1]); w.w = cvt_pk_bf16(c[2], c[3]);
            *(u32x4*)((which ? VL : KL) + (size_t)b * LAT_KEYS * 1024 + e) = w;
        }
        if (gt < 1024) {
            const int p = gt >> 4, f = gt & 15;
            const float inv = exp2f(-(float)f * (13.287712379549449f / 16.0f));
            const float ang = (float)p * inv; double s, c; sincos_d((double)ang, s, c);
            ROPE[gt * 2] = (float)c; ROPE[gt * 2 + 1] = (float)s;
        }
        if (gt == 0) { float s1 = 0.f, s2 = 0.f; for (int i = 0; i < 64; ++i) { s1 += lam_p[i] * lam_p[64 + i]; s2 += lam_p[128 + i] * lam_p[192 + i]; }
            MISCW[0] = expf(s1) - expf(s2) + LAM_INIT; }
    }
    SEAM(0);

    if (IN(1)) REPEAT(REP_P0B) {
        LAS float* SS = (LAS float*)ldsl;
        const int rows_per = (MTOK + G - 1) / G, r0 = bx * rows_per, r1 = (r0 + rows_per < MTOK) ? r0 + rows_per : MTOK;
        if (r0 < MTOK) {
            const int mb0 = r0 < M_CTX ? 0 : 1 + ((r0 - M_CTX) >> 11), mb1 = (r1 - 1) < M_CTX ? 0 : 1 + ((r1 - 1 - M_CTX) >> 11);
            for (int i = tid; i < 4096; i += NWAVES * 64) { const int which = i >> 11, cidx = i & 2047, mb = which ? mb1 : mb0;
                float s = b_mod[cidx];
#pragma unroll
                for (int ks = 0; ks < 16; ++ks) s += MODP[((size_t)ks * 5 + mb) * 3072 + cidx];
                SS[i] = s; }
        }
        if (bx < 60 && tid < 256) {
            const int j = bx / 12, cidx = (bx % 12) * 256 + tid; float s = b_mod[cidx];
#pragma unroll
            for (int ks = 0; ks < 16; ++ks) s += MODP[((size_t)ks * 5 + j) * 3072 + cidx];
            MODF[j * 3072 + cidx] = s;
        }
        __syncthreads();
        if (r0 < MTOK) {
            const int mb0 = r0 < M_CTX ? 0 : 1 + ((r0 - M_CTX) >> 11);
            for (int m = r0 + wave; m < r1; m += NWAVES) {
                const float* xrow = m < M_CTX ? x_prompt + (size_t)m * DM : x_sample + (size_t)(m - M_CTX) * DM;
                const int mb = m < M_CTX ? 0 : 1 + ((m - M_CTX) >> 11);
                const LAS float* sp = SS + (mb == mb0 ? 0 : 2048);
                const f32x4* xr = (const f32x4*)xrow + lane;
                f32x4 v[4]; float s = 0.f;
#pragma unroll
                for (int j = 0; j < 4; ++j) { v[j] = xr[64 * j]; s += (v[j].x + v[j].y) + (v[j].z + v[j].w); }
                const float mean = wave_sum(s) * (1.f / DM); float s2 = 0.f;
#pragma unroll
                for (int j = 0; j < 4; ++j) { v[j] = v[j] - mean; s2 += (v[j].x * v[j].x + v[j].y * v[j].y) + (v[j].z * v[j].z + v[j].w * v[j].w); }
                const float rstd = 1.f / sqrtf(wave_sum(s2) * (1.f / DM) + MOD_EPS);
                u32x2* o8 = (u32x2*)(HB + (size_t)m * DM) + lane;
#pragma unroll
                for (int j = 0; j < 4; ++j) { const int cidx = 256 * j + 4 * lane;
                    const f32x4 sh = *(const LAS f32x4*)(sp + cidx), sc = *(const LAS f32x4*)(sp + 1024 + cidx);
                    const f32x4 hv = v[j] * rstd * (sc + 1.f) + sh;
                    u32x2 w; w.x = cvt_pk_bf16(hv[0], hv[1]); w.y = cvt_pk_bf16(hv[2], hv[3]); o8[64 * j] = w; }
            }
        }
        __syncthreads();
    }
    SEAM(1);

    if (IN(2)) {
        pg8::Gemm g{HB, WCAT, HB, WCAT, MTOK, N_CAT, DM}; pg8::StaticOrder S; S.init(MTOK, N_CAT, G, bx, REP_P1);
        pg8::EpiProj E{QA, ZA, QR, KR, VR, ZR, GT, KC, VC, KL, VL, dout + OUT_K, dout + OUT_V, ROPE, b_gate};
        pg8::gemm_phase<pg8::EpiProj, pg8::StaticOrder, true, true>(ldsl, g, S, E);
    }
    SEAM(2);

    if (IN(3)) {
        const float lam = MISCW[0];
        constexpr int N_LAT_U = LAT_B * NH * (LAT_N / 128), N_CTX_U = CTX_B * NH * (CTX_N / 128), N_R1 = NCHUNK * NH;
        REPEAT(REP_P2A) for (int it = vcu; it < N_LAT_U + N_CTX_U; it += G) {
            size_t qoff, koff; const bf16_t* Kb; const bf16_t* Vb; int seq;
            if (it < N_LAT_U) {
                const int bh = it >> 4, qb = it & 15, b = bh >> 3, h = bh & 7;
                qoff = ((size_t)(M_CTX + b * LAT_N + qb * 128)) * 1024 + h * 128; koff = (size_t)b * LAT_KEYS * 1024 + h * 128; Kb = KL; Vb = VL; seq = LAT_KEYS;
            } else {
                const int u = it - N_LAT_U, bh = u >> 1, qb = u & 1, b = bh >> 3, h = bh & 7;
                qoff = ((size_t)(b * CTX_N + qb * 128)) * 1024 + h * 128; koff = (size_t)b * CTX_N * 1024 + h * 128; Kb = KC; Vb = VC; seq = CTX_N;
            }
            att::attn_unit(QA + qoff, Kb + koff, Vb + koff, seq, lam, subln_g, ZA + qoff, (rep_ + 1 < REP_P2A) ? (bf16_t*)(ws + WS_END) : QA + qoff, (char*)lds);
        }
        REPEAT(REP_P2B) for (int u = vcu; u < N_R1; u += G) {
            const int gc = u >> 3, h = u & 7;
            att::ret_local_unit(KR + (size_t)gc * 128 * 512 + h * 64, VR + (size_t)gc * 128 * 1024 + h * 128, log2_gamma(ret_decay[h]), log2_gamma(ret_decay[8 + h]), LST + (size_t)u * 16384, (char*)lds);
        }
    }
    SEAM(3);

    if (IN(4)) REPEAT(REP_P3) {
        for (int idx = gt; idx < 160 * 4096; idx += NGT) {
            const int chain = idx >> 12, rem = idx & 4095, dir = rem >> 11, e = (rem & 2047) * 4;
            int b, h, nc, gc0; f32x4 S;
            if (chain < 128) { b = chain >> 3; h = chain & 7; nc = 2; gc0 = b * 2; S = (f32x4){0.f, 0.f, 0.f, 0.f}; }
            else { const int cb = chain - 128; b = cb >> 3; h = cb & 7; nc = 16; gc0 = 32 + b * 16; S = *(const f32x4*)((dir ? st_b : st_f) + (size_t)(b * 8 + h) * 8192 + e); }
            const float dec = exp2f(log2_gamma(ret_decay[dir * 8 + h]) * 128.f);
            for (int cc = 0; cc < nc; ++cc) {
                const int c = dir ? nc - 1 - cc : cc; const size_t u = (size_t)(gc0 + c) * 8 + h;
                u32x2 w; w.x = cvt_pk_bf16(S[0], S[1]); w.y = cvt_pk_bf16(S[2], S[3]);
                *(u32x2*)(PST + (u * 2 + dir) * 8192 + e) = w;
                S = S * dec + *(const f32x4*)(LST + u * 16384 + dir * 8192 + e);
            }
            if (chain < 128) *(f32x4*)(dout + (dir ? OUT_SB : OUT_SF) + (size_t)(b * 8 + h) * 8192 + e) = S;
        }
    }
    SEAM(4);

    if (IN(5)) REPEAT(REP_P4) {
        for (int u = vcu; u < NCHUNK * NH; u += G) {
            const int gc = u >> 3, h = u & 7; const size_t t0 = (size_t)gc * 128;
            att::ret_out_unit(QR + t0 * 512 + h * 64, KR + t0 * 512 + h * 64, VR + t0 * 1024 + h * 128, PST + ((size_t)u * 2) * 8192, PST + ((size_t)u * 2 + 1) * 8192,
                              log2_gamma(ret_decay[h]), log2_gamma(ret_decay[8 + h]), ret_gn_g + h * 128, ZR + t0 * 1024 + h * 128, (rep_ + 1 < REP_P4) ? (bf16_t*)(ws + WS_END) : VR + t0 * 1024 + h * 128, (char*)lds);
        }
    }
    SEAM(5);

    if (IN(6)) {
        pg8::Gemm g{QA, WPA, VR, WPR, MTOK, DM, DM}; pg8::PanelOrder<true> S{bx, REP_P5};
        pg8::EpiMerge E{GT, ZA};
        pg8::gemm_phase<pg8::EpiMerge, pg8::PanelOrder<true>, true, true>(ldsl, g, S, E);
    }
    SEAM(6);

    if (IN(7)) {
        pg8::Gemm g{ZA, WOUT, ZA, WOUT, MTOK, DM, DM}; pg8::PanelOrder<false> S{bx, 1};
        pg8::EpiOut E{x_prompt, x_sample, MODF, dout + OUT_Y, STATS};
        pg8::gemm_phase<pg8::EpiOut, pg8::PanelOrder<false>, false, true>(ldsl, g, S, E);
    }
    SEAM(7);

    if (IN(8)) REPEAT(REP_P7) {
        for (int m = gw; m < MTOK; m += NGW) {
            const f32x4 s0 = *(const f32x4*)(STATS + (size_t)m * 8), s1 = *(const f32x4*)(STATS + (size_t)m * 8 + 4);
            const float mean = (s0[0] + s0[2] + s1[0] + s1[2]) * 0.25f;
            const float d0 = s0[0] - mean, d1 = s0[2] - mean, d2 = s1[0] - mean, d3 = s1[2] - mean;
            const float m2 = (s0[1] + s0[3]) + (s1[1] + s1[3]) + 256.f * ((d0 * d0 + d1 * d1) + (d2 * d2 + d3 * d3));
            const float rstd = 1.f / sqrtf(m2 * (1.f / DM) + LN_EPS);
            f32x4* yr = (f32x4*)(dout + OUT_Y + (size_t)m * DM) + lane;
            f32x4* yw = (rep_ + 1 < REP_P7) ? (f32x4*)(ws + WS_END) + lane : yr;
#pragma unroll
            for (int j = 0; j < 4; ++j) { const int cidx = 256 * j + 4 * lane; const f32x4 v = yr[64 * j];
                yw[64 * j] = (v - mean) * rstd * *(const f32x4*)(ln_g + cidx) + *(const f32x4*)(ln_b + cidx); }
        }
    }
#undef IN
#undef SEAM
}

extern "C" void kernel_launch(void* const* d_in, const int* in_sizes, int n_in, void* d_out, int out_size, void* d_ws, size_t ws_size, hipStream_t stream) {
    static int grid = 0;
    if (grid == 0) {
        if (n_in != 22 || out_size != (int)OUT_END || ws_size < WS_END) { fprintf(stderr, "kernel_launch: unexpected shapes: n_in %d out %d ws %zu (need >= %zu); nothing launched\n", n_in, out_size, ws_size, (size_t)WS_END); grid = -1; return; }
        int dev = 0, cus = 0, per_cu = 0;
        if (hipGetDevice(&dev) != hipSuccess || hipDeviceGetAttribute(&cus, hipDeviceAttributeMultiprocessorCount, dev) != hipSuccess) { fprintf(stderr, "kernel_launch: device query failed\n"); grid = -1; return; }
        if (hipFuncSetAttribute((const void*)mk_fwd, hipFuncAttributeMaxDynamicSharedMemorySize, LDS_BYTES) != hipSuccess) { fprintf(stderr, "kernel_launch: hipFuncSetAttribute failed\n"); grid = -1; return; }
        if (hipOccupancyMaxActiveBlocksPerMultiprocessor(&per_cu, (const void*)mk_fwd, NWAVES * 64, LDS_BYTES) != hipSuccess || per_cu < 1) {
            fprintf(stderr, "kernel_launch: occupancy query reports %d workgroups per CU\n", per_cu); }
        (void)hipGetLastError();
        grid = cus;
        if (grid != 256) fprintf(stderr, "kernel_launch: %d CUs; the panel phases expect 256\n", grid);
    }
    if (grid < 0) return;
    (void)hipMemsetAsync((char*)d_ws + WS_CTL, 0, CTL_ZERO_BYTES, stream);
    Args a{};
    for (int i = 0; i < 22; ++i) a.in[i] = (const float*)d_in[i];
    a.out = (float*)d_out; a.ws = (unsigned char*)d_ws;
#if MK_N_LAUNCHES == 1
    a.ph_lo = 0; a.ph_hi = N_PHASES;
    hipLaunchKernelGGL(mk_fwd, dim3(grid), dim3(NWAVES * 64), LDS_BYTES, stream, a);
#else
    for (int p = 0; p < N_PHASES; ++p) { a.ph_lo = p; a.ph_hi = p + 1; hipLaunchKernelGGL(mk_fwd, dim3(grid), dim3(NWAVES * 64), LDS_BYTES, stream, a); }
#endif
    const hipError_t le = hipPeekAtLastError();
    if (le != hipSuccess) fprintf(stderr, "kernel_launch: launch failed: %s\n", hipGetErrorName(le));
}
```

```cpp
#include <hip/hip_runtime.h>
#include <cstdio>
#include <cstdint>

#define GAS __attribute__((address_space(1)))
#define LAS __attribute__((address_space(3)))
typedef unsigned short bf16_t;
typedef short bf16x8 __attribute__((ext_vector_type(8)));
typedef short s16x4 __attribute__((ext_vector_type(4)));
typedef float f32x2 __attribute__((ext_vector_type(2)));
typedef float f32x4 __attribute__((ext_vector_type(4)));
typedef float f32x8 __attribute__((ext_vector_type(8)));
typedef float f32x16 __attribute__((ext_vector_type(16)));
typedef unsigned u32x2 __attribute__((ext_vector_type(2)));
typedef unsigned u32x4 __attribute__((ext_vector_type(4)));
typedef int i32x4 __attribute__((ext_vector_type(4)));
typedef int i32x8 __attribute__((ext_vector_type(8)));

constexpr int DM = 1024;
constexpr int M_CTX = 4096, M_LAT = 8192, MTOK = M_CTX + M_LAT;
constexpr int N_IN = 7168, N_GATE = 2048, N_CAT = N_IN + N_GATE;
constexpr int NH = 8;
constexpr int CTX_B = 16, CTX_N = 256, LAT_B = 4, LAT_N = 2048, PAST = 256, LAT_KEYS = PAST + LAT_N;
constexpr int NCHUNK = MTOK / 128;
constexpr float LN_EPS = 1e-5f, MOD_EPS = 1e-6f;
constexpr float DN_ALPHA = 1.189207115002721f;
constexpr float LAM_INIT = 0.2f;

__device__ __forceinline__ unsigned cvt_pk_bf16(float lo, float hi) { unsigned r; asm volatile("v_cvt_pk_bf16_f32 %0, %1, %2" : "=v"(r) : "v"(lo), "v"(hi)); return r; }
__device__ __forceinline__ float bf_lo(unsigned w) { return __uint_as_float(w << 16); }
__device__ __forceinline__ float bf_hi(unsigned w) { return __uint_as_float(w & 0xffff0000u); }
__device__ __forceinline__ float bf2f(bf16_t h) { return __uint_as_float((unsigned)h << 16); }
__device__ __forceinline__ float clamp8(float v) { return __builtin_fminf(__builtin_fmaxf(v, -448.f), 448.f); }
__device__ __forceinline__ unsigned cvt4_fp8(float a, float b, float c, float d) {
    int w = __builtin_amdgcn_cvt_pk_fp8_f32(clamp8(a), clamp8(b), 0, false); w = __builtin_amdgcn_cvt_pk_fp8_f32(clamp8(c), clamp8(d), w, true); return (unsigned)w; }
__device__ __forceinline__ float fast_rcp(float x) { return __builtin_amdgcn_rcpf(x); }
__device__ __forceinline__ float silu_f(float v) { return v * fast_rcp(1.f + __builtin_amdgcn_exp2f(-1.4426950408889634f * v)); }
__device__ __forceinline__ float sigmoid_f(float v) { return fast_rcp(1.f + __builtin_amdgcn_exp2f(-1.4426950408889634f * v)); }

namespace pg8 {
#define PG8_LAS __attribute__((address_space(3)))
constexpr int BM = 256, BK = 64, HALF = 128, HTB = HALF * BK * 2  , STAGE_BYTES = 8 * HTB, NXCD = 8, WGM = 8;

__host__ __device__ __forceinline__ int lds_byte(int r, int c) { const int st = (r >> 4) * 2 + (c >> 5), rr = r & 15, cc = c & 31, ob = rr * 64 + cc * 2; return st * 1024 + (ob ^ (((ob >> 9) & 1) << 5)); }
__host__ __device__ __forceinline__ void stage_rc(int b, int& R, int& C) { const int st = b / 1024, sb = b % 1024, swz = sb ^ (((sb >> 9) & 1) << 5); R = (st >> 1) * 16 + swz / 64; C = (st & 1) * 32 + (swz % 64) / 2; }
__host__ __device__ __forceinline__ int perm32(int rho) { const int n = rho >> 4, i = rho & 15; return 8 * (i >> 2) + 4 * n + (i & 3); }

struct Unit { int pm, pn, sel, pe; };
struct Gemm { const void* A; const void* Bt; const void* A2; const void* Bt2; int pitchA, ktA, pitchB, ktB, nt, sW, sX; };

__host__ __device__ __forceinline__ void tile_map(int L, int nM, int nN, int& pm, int& pn) {
    const int nwg = nM * nN; int wgid = L;
    { const int q = nwg / NXCD, r = nwg % NXCD, xcd = wgid % NXCD, off = wgid / NXCD; wgid = (xcd < r ? xcd * (q + 1) : r * (q + 1) + (xcd - r) * q) + off; }
    const int nig = WGM * nN, gid = wgid / nig, fm = gid * WGM, gsz = (nM - fm) < WGM ? (nM - fm) : WGM;
    pm = fm + ((wgid % nig) % gsz); pn = (wgid % nig) / gsz;
}
struct KvOrder {
    int G, c, rep;
    __device__ __forceinline__ bool next(int i, Unit& u) const {
        long L = (long)i * G + c; if (L >= (long)(16 * 14) * rep) return false; L %= 16 * 14;
        tile_map((int)L, 16, 14, u.pm, u.pn); u.sel = 0; u.pe = u.pn < 8 ? u.pn + 4 : u.pn + 10; return true;
    }
    __device__ __forceinline__ void a_ready(const Unit&) const {}
    __device__ __forceinline__ void done(const Unit&) const {}
};
struct ProjOrder8 {
    int G, c, rep;
    __device__ __forceinline__ bool next(int i, Unit& u) const {
        constexpr int NL = 32 * 36, NC = 16 * 22;
        long L = (long)i * G + c; if (L >= (long)(NL + NC) * rep) return false; L %= (NL + NC);
        if (L < NL) { tile_map((int)L, 32, 36, u.pm, u.pn); u.pm += 16; }
        else { int q; tile_map((int)L - NL, 16, 22, u.pm, q); u.pn = q < 4 ? q : (q < 10 ? q + 8 : q + 14); }
        u.sel = 0; u.pe = u.pn; return true;
    }
    __device__ __forceinline__ void a_ready(const Unit&) const {}
    __device__ __forceinline__ void done(const Unit&) const {}
};
template <bool PAIR> struct PanelOrder {
    int c, rep;
    __device__ __forceinline__ bool next(int i, Unit& u) const {
        const int xcd = c & 7, idx = c >> 3;
        if (idx >= 24 || i >= (PAIR ? 2 : 1) * rep) return false;
        u.pm = xcd * 6 + (idx >> 2); u.pn = idx & 3; u.pe = u.pn; u.sel = PAIR ? (i & 1) : 0; return true;
    }
    __device__ __forceinline__ void a_ready(const Unit&) const {}
    __device__ __forceinline__ void done(const Unit&) const {}
};


struct EpiProj {
    static constexpr bool PERM = true, AFTER_DRAIN = false;
    __device__ static __forceinline__ bool keep_acc(const Unit&) { return false; }
    bf16_t *QA, *ZA, *QR, *KR, *VR, *ZR, *G, *KC, *VC, *KL, *VL;
    float *outK, *outV; const float* rope; const float* b_gate;
    __device__ __forceinline__ static void st8(bf16_t* p, const f32x4& a, const f32x4& b) {
        u32x4 w; w.x = cvt_pk_bf16(a[0], a[1]); w.y = cvt_pk_bf16(a[2], a[3]); w.z = cvt_pk_bf16(b[0], b[1]); w.w = cvt_pk_bf16(b[2], b[3]); *(u32x4*)p = w; }
    __device__ __forceinline__ void rope8(f32x4& a, f32x4& b, int pos, int dcol) const {
        const int i0 = dcol >> 1, p = (i0 < 16) ? (pos >> 6) : (pos & 63), f0 = i0 & 15;
        const f32x4 t0 = *(const f32x4*)(rope + (p * 16 + f0) * 2), t1 = *(const f32x4*)(rope + (p * 16 + f0) * 2 + 4);
        f32x4 ra, rb;
        ra[0] = a[0] * t0[0] - a[1] * t0[1]; ra[1] = a[0] * t0[1] + a[1] * t0[0]; ra[2] = a[2] * t0[2] - a[3] * t0[3]; ra[3] = a[2] * t0[3] + a[3] * t0[2];
        rb[0] = b[0] * t1[0] - b[1] * t1[1]; rb[1] = b[0] * t1[1] + b[1] * t1[0]; rb[2] = b[2] * t1[2] - b[3] * t1[3]; rb[3] = b[2] * t1[3] + b[3] * t1[2];
        a = ra; b = rb;
    }
    __device__ __forceinline__ void operator()(f32x4 (&acc)[2][2][4][2], const Unit& u, int wr, int wc, int fr, int fq) const {
        const int pn = u.pe; const bool ctx = u.pm < (M_CTX / BM);
        const int row0 = u.pm * BM + wr * 64 + fr;
        int seg, cs0;
        if (pn < 4) { seg = 0; cs0 = pn * 256; } else if (pn < 8) { seg = 1; cs0 = (pn - 4) * 256; } else if (pn < 12) { seg = 2; cs0 = (pn - 8) * 256; }
        else if (pn < 16) { seg = 3; cs0 = (pn - 12) * 256; } else if (pn < 18) { seg = 4; cs0 = (pn - 16) * 256; } else if (pn < 20) { seg = 5; cs0 = (pn - 18) * 256; }
        else if (pn < 24) { seg = 6; cs0 = (pn - 20) * 256; } else if (pn < 28) { seg = 7; cs0 = (pn - 24) * 256; } else { seg = 8; cs0 = (pn - 28) * 256; }
        const int colw = cs0 + wc * 32 + 8 * fq;
#pragma unroll
        for (int ai = 0; ai < 2; ++ai)
#pragma unroll
            for (int m = 0; m < 4; ++m) {
                const int row = row0 + ai * HALF + m * 16;
                const int lrow = row - M_CTX, lb = lrow >> 11, pos = lrow & (LAT_N - 1);
#pragma unroll
                for (int bj = 0; bj < 2; ++bj) {
                    const int col = colw + bj * HALF;
                    f32x4 v0 = acc[ai][bj][m][0], v1 = acc[ai][bj][m][1];
                    if (seg == 0) {
                        if (!ctx) rope8(v0, v1, pos, col & 63);
                        st8(QA + (size_t)row * 1024 + col, v0, v1);
                    } else if (seg == 1) {
                        if (ctx) { float* o = outK + (size_t)row * 1024 + col; *(f32x4*)o = v0; *(f32x4*)(o + 4) = v1; st8(KC + (size_t)row * 1024 + col, v0, v1); }
                        else { rope8(v0, v1, pos, col & 63); st8(KL + ((size_t)lb * LAT_KEYS + PAST + pos) * 1024 + col, v0, v1); }
                    } else if (seg == 2) {
                        if (ctx) { float* o = outV + (size_t)row * 1024 + col; *(f32x4*)o = v0; *(f32x4*)(o + 4) = v1; st8(VC + (size_t)row * 1024 + col, v0, v1); }
                        else st8(VL + ((size_t)lb * LAT_KEYS + PAST + pos) * 1024 + col, v0, v1);
                    } else if (seg == 3 || seg == 7) {
#pragma unroll
                        for (int k = 0; k < 4; ++k) { v0[k] = silu_f(v0[k]); v1[k] = silu_f(v1[k]); }
                        st8((seg == 3 ? ZA : ZR) + (size_t)row * 1024 + col, v0, v1);
                    } else if (seg == 4) {
                        st8(QR + (size_t)row * 512 + col, v0, v1);
                    } else if (seg == 5) {
                        v0 = v0 * 0.125f; v1 = v1 * 0.125f; st8(KR + (size_t)row * 512 + col, v0, v1);
                    } else if (seg == 6) {
                        st8(VR + (size_t)row * 1024 + col, v0, v1);
                    } else {
                        const f32x4 b0 = *(const f32x4*)(b_gate + col), b1 = *(const f32x4*)(b_gate + col + 4);
#pragma unroll
                        for (int k = 0; k < 4; ++k) { v0[k] = sigmoid_f(v0[k] + b0[k]); v1[k] = sigmoid_f(v1[k] + b1[k]); }
                        st8(G + (size_t)row * 2048 + col, v0, v1);
                    }
                }
            }
    }
};

struct EpiMerge {
    static constexpr bool PERM = true, AFTER_DRAIN = false;
    __device__ static __forceinline__ bool keep_acc(const Unit& u) { return u.sel == 0; }
    const bf16_t* G; unsigned char* Mo; float oscale;
    __device__ __forceinline__ void operator()(f32x4 (&acc)[2][2][4][2], const Unit& u, int wr, int wc, int fr, int fq) const {
        const int row0 = u.pm * BM + wr * 64 + fr, col0 = u.pn * BM + wc * 32 + 8 * fq;
#pragma unroll
        for (int ai = 0; ai < 2; ++ai)
#pragma unroll
            for (int m = 0; m < 4; ++m) {
                const int row = row0 + ai * HALF + m * 16;
#pragma unroll
                for (int bj = 0; bj < 2; ++bj) {
                    const int col = col0 + bj * HALF;
                    const u32x4 gr = *(const u32x4*)(G + (size_t)row * 2048 + 1024 + col);
                    if (u.sel == 0) {
                        const u32x4 ga = *(const u32x4*)(G + (size_t)row * 2048 + col);
                        f32x4 r0, r1;
                        r0[0] = bf_lo(ga.x) * fast_rcp(bf_lo(gr.x)); r0[1] = bf_hi(ga.x) * fast_rcp(bf_hi(gr.x)); r0[2] = bf_lo(ga.y) * fast_rcp(bf_lo(gr.y)); r0[3] = bf_hi(ga.y) * fast_rcp(bf_hi(gr.y));
                        r1[0] = bf_lo(ga.z) * fast_rcp(bf_lo(gr.z)); r1[1] = bf_hi(ga.z) * fast_rcp(bf_hi(gr.z)); r1[2] = bf_lo(ga.w) * fast_rcp(bf_lo(gr.w)); r1[3] = bf_hi(ga.w) * fast_rcp(bf_hi(gr.w));
                        acc[ai][bj][m][0] = acc[ai][bj][m][0] * r0; acc[ai][bj][m][1] = acc[ai][bj][m][1] * r1;
                    } else {
                        f32x4 g0, g1;
                        g0[0] = bf_lo(gr.x); g0[1] = bf_hi(gr.x); g0[2] = bf_lo(gr.y); g0[3] = bf_hi(gr.y); g1[0] = bf_lo(gr.z); g1[1] = bf_hi(gr.z); g1[2] = bf_lo(gr.w); g1[3] = bf_hi(gr.w);
                        const f32x4 v0 = acc[ai][bj][m][0] * g0, v1 = acc[ai][bj][m][1] * g1;
                        const f32x4 s0 = v0 * oscale, s1 = v1 * oscale;
                        u32x2 w; w.x = cvt4_fp8(s0[0], s0[1], s0[2], s0[3]); w.y = cvt4_fp8(s1[0], s1[1], s1[2], s1[3]);
                        *(u32x2*)(Mo + (size_t)row * 1024 + col) = w;
                    }
                }
            }
    }
};

struct EpiOut {
    static constexpr bool PERM = false, AFTER_DRAIN = true;
    __device__ static __forceinline__ bool keep_acc(const Unit&) { return false; }
    const float* xc; const float* xl; const float* modf; float* out; float* stats;
    __device__ __forceinline__ void operator()(f32x4 (&)[2][2][4][2], const Unit&, int, int, int, int) const {}
    __device__ __forceinline__ void fused(f32x4 (&acc)[2][2][4][2], const Unit& u, int wr, int wc, int fr, int fq, PG8_LAS unsigned char* lds, int wid, int lane) const {
        PG8_LAS f32x2* P = (PG8_LAS f32x2*)lds;
        const bool ctx = u.pm < (M_CTX / BM);
        const int mb = ctx ? 0 : 1 + ((u.pm * BM - M_CTX) >> 11);
        const float* xb = ctx ? xc + (size_t)(u.pm * BM) * DM : xl + (size_t)(u.pm * BM - M_CTX) * DM;
        const int col0 = u.pn * BM + wc * 32 + 4 * fq;
        f32x4 gv[2][2];
#pragma unroll
        for (int bj = 0; bj < 2; ++bj)
#pragma unroll
            for (int n = 0; n < 2; ++n) gv[bj][n] = *(const f32x4*)(modf + mb * 3072 + 2048 + col0 + bj * HALF + n * 16);
#pragma unroll
        for (int ai = 0; ai < 2; ++ai)
#pragma unroll
            for (int m = 0; m < 4; ++m) {
                const int rl = ai * HALF + wr * 64 + m * 16 + fr;
                float s = 0.f;
#pragma unroll
                for (int bj = 0; bj < 2; ++bj)
#pragma unroll
                    for (int n = 0; n < 2; ++n) {
                        const f32x4 xv = *(const f32x4*)(xb + (size_t)rl * DM + col0 + bj * HALF + n * 16);
                        const f32x4 v = xv * DN_ALPHA + gv[bj][n] * acc[ai][bj][m][n];
                        acc[ai][bj][m][n] = v; s += (v[0] + v[1]) + (v[2] + v[3]);
                        *(f32x4*)(out + (size_t)(u.pm * BM + rl) * DM + col0 + bj * HALF + n * 16) = v;
                    }
                s += __shfl_xor(s, 16); s += __shfl_xor(s, 32);
                const float mw = s * (1.0f / 64.0f); float q = 0.f;
#pragma unroll
                for (int bj = 0; bj < 2; ++bj)
#pragma unroll
                    for (int n = 0; n < 2; ++n) { const f32x4 d = acc[ai][bj][m][n] - mw; q += (d[0] * d[0] + d[1] * d[1]) + (d[2] * d[2] + d[3] * d[3]); }
                q += __shfl_xor(q, 16); q += __shfl_xor(q, 32);
                if (fq == 0) P[rl * 4 + wc] = (f32x2){mw, q};
            }
        asm volatile("s_waitcnt lgkmcnt(0)" ::: "memory"); __builtin_amdgcn_s_barrier(); asm volatile("" ::: "memory");
        const int row = wid * 32 + (lane & 31);
        if (lane < 32) {
            const f32x2 a = P[row * 4 + 0], b = P[row * 4 + 1], c = P[row * 4 + 2], d = P[row * 4 + 3];
            const float mt = (a.x + b.x + c.x + d.x) * 0.25f;
            const float da = a.x - mt, db = b.x - mt, dc = c.x - mt, dd = d.x - mt;
            const float m2 = (a.y + b.y) + (c.y + d.y) + 64.0f * ((da * da + db * db) + (dc * dc + dd * dd));
            *(f32x2*)(stats + ((size_t)(u.pm * BM + row) * 4 + u.pn) * 2) = (f32x2){mt, m2};
        }
    }
};

template <class Epi, class Sched, bool ALIGN_EPI = false, bool SP2 = false, bool FP8 = false>
__device__ __forceinline__ void gemm_phase(PG8_LAS unsigned char* lds, const Gemm g, const Sched& S, const Epi& E) {
    const int tid = threadIdx.x, wid = __builtin_amdgcn_readfirstlane(tid >> 6), lane = tid & 63, wr = wid >> 2, wc = wid & 3, fr = lane & 15, fq = lane >> 4;
    const int nt = g.nt;
    unsigned voffA[2], voffB[2];
#pragma unroll
    for (int i = 0; i < 2; ++i) { int R, C; stage_rc(tid * 16 + i * 8192, R, C); const int Rb = Epi::PERM ? ((R & ~31) + perm32(R & 31)) : R;
        voffA[i] = (unsigned)(R * g.pitchA + C * 2); voffB[i] = (unsigned)(Rb * g.pitchB + C * 2); }
    const size_t kstepA = (size_t)g.ktA, kstepB = (size_t)g.ktB;
    const size_t hstepA = (size_t)HALF * g.pitchA, hstepB = (size_t)HALF * g.pitchB;
    const size_t tstepA = 2 * hstepA, tstepB = 2 * hstepB;
    const unsigned ldsw = (unsigned)wid * 1024u;
    const int aoff = lds_byte(wr * 64 + fr, fq * 8), boff = lds_byte(wc * 32 + fr, fq * 8);
#define PG8_SA(b, h) (((b) * 2 + (h)) * HTB)
#define PG8_SB(b, h) ((4 + (b) * 2 + (h)) * HTB)
#define PG8_STAGE(bufoff, gbase, voff) do { _Pragma("unroll") for (int _i = 0; _i < 2; ++_i) \
        __builtin_amdgcn_global_load_lds((const unsigned*)((const char*)(gbase) + (voff)[_i]), (PG8_LAS unsigned*)(lds + (bufoff) + ldsw + _i * 8192), 16, 0, 0); } while (0)
#define PG8_LDA(dst, b, h) do { _Pragma("unroll") for (int m = 0; m < 4; ++m) _Pragma("unroll") for (int k = 0; k < 2; ++k) dst[m][k] = *(const PG8_LAS bf16x8*)(lds + PG8_SA(b, h) + aoff + m * 2048 + k * 1024); } while (0)
#define PG8_LDB(dst, b, h) do { _Pragma("unroll") for (int n = 0; n < 2; ++n) _Pragma("unroll") for (int k = 0; k < 2; ++k) dst[n][k] = *(const PG8_LAS bf16x8*)(lds + PG8_SB(b, h) + boff + n * 2048 + k * 1024); } while (0)
#define PG8_CAT8(lo, hi) __builtin_shufflevector(__builtin_bit_cast(i32x4, lo), __builtin_bit_cast(i32x4, hi), 0, 1, 2, 3, 4, 5, 6, 7)
#define PG8_MMA(ai, bj, At, Bt) do { __builtin_amdgcn_s_setprio(1); if constexpr (FP8) { _Pragma("unroll") for (int m = 0; m < 4; ++m) _Pragma("unroll") for (int n = 0; n < 2; ++n) \
        asm volatile("s_nop 1\n\tv_mfma_scale_f32_16x16x128_f8f6f4 %0, %1, %2, %0, %3, %4 op_sel_hi:[0,0,0]" : "+v"(acc[ai][bj][m][n]) : "v"(PG8_CAT8(Bt[n][0], Bt[n][1])), "v"(PG8_CAT8(At[m][0], At[m][1])), "v"(sWv), "v"(sXv)); } else { \
        _Pragma("unroll") for (int m = 0; m < 4; ++m) _Pragma("unroll") for (int n = 0; n < 2; ++n) _Pragma("unroll") for (int k = 0; k < 2; ++k) \
        acc[ai][bj][m][n] = __builtin_amdgcn_mfma_f32_16x16x32_bf16(Bt[n][k], At[m][k], acc[ai][bj][m][n], 0, 0, 0); } __builtin_amdgcn_s_setprio(0); } while (0)
#define PG8_WAIT_V(n) asm volatile("s_waitcnt vmcnt(" #n ")" ::: "memory")
#define PG8_WAIT_L(n) asm volatile("s_waitcnt lgkmcnt(" #n ")" ::: "memory")
#define PG8_BAR __builtin_amdgcn_s_barrier()
#define PG8_SCHED __builtin_amdgcn_sched_barrier(0)
    int sWv = g.sW, sXv = g.sX;
    Unit cur, nxt; int ui = 0;
    if (!S.next(0, cur)) return;
    f32x4 acc[2][2][4][2];
#pragma unroll
    for (int a = 0; a < 2; ++a)
#pragma unroll
        for (int b = 0; b < 2; ++b)
#pragma unroll
            for (int m = 0; m < 4; ++m)
#pragma unroll
                for (int n = 0; n < 2; ++n) acc[a][b][m][n] = (f32x4){0.f, 0.f, 0.f, 0.f};
    bf16x8 At[4][2], B0[2][2], B1[2][2];
    const char* cA = (const char*)(cur.sel ? g.A2 : g.A) + (size_t)cur.pm * tstepA; const char* cB = (const char*)(cur.sel ? g.Bt2 : g.Bt) + (size_t)cur.pn * tstepB;
    S.a_ready(cur);
    if constexpr (SP2) {
        PG8_STAGE(PG8_SB(0, 0), cB, voffB); PG8_STAGE(PG8_SB(0, 1), cB + hstepB, voffB); PG8_STAGE(PG8_SA(0, 0), cA, voffA); PG8_STAGE(PG8_SA(0, 1), cA + hstepA, voffA);
        if (wr == 1) PG8_BAR;
        PG8_WAIT_V(2); PG8_BAR;
        PG8_STAGE(PG8_SB(1, 0), cB + kstepB, voffB); PG8_STAGE(PG8_SA(1, 0), cA + kstepA, voffA); PG8_STAGE(PG8_SB(1, 1), cB + hstepB + kstepB, voffB);
        PG8_WAIT_V(6); PG8_BAR;
    } else {
        PG8_STAGE(PG8_SB(0, 0), cB, voffB); PG8_STAGE(PG8_SA(0, 0), cA, voffA); PG8_STAGE(PG8_SB(0, 1), cB + hstepB, voffB); PG8_STAGE(PG8_SA(0, 1), cA + hstepA, voffA);
        if (wr == 1) PG8_BAR;
        PG8_WAIT_V(4); PG8_BAR;
        PG8_STAGE(PG8_SB(1, 0), cB + kstepB, voffB); PG8_STAGE(PG8_SA(1, 0), cA + kstepA, voffA); PG8_STAGE(PG8_SB(1, 1), cB + hstepB + kstepB, voffB);
        PG8_WAIT_V(6); PG8_BAR;
    }
    for (;;) {
        const bool has_next = S.next(ui + 1, nxt);
        const char* nA = has_next ? (const char*)(nxt.sel ? g.A2 : g.A) + (size_t)nxt.pm * tstepA : cA; const char* nB = has_next ? (const char*)(nxt.sel ? g.Bt2 : g.Bt) + (size_t)nxt.pn * tstepB : cB;
#pragma unroll 1
        for (int t = 0; t < nt; t += 2) {
            const bool last = (t == nt - 2);
            asm volatile("" : "+s"(cA), "+s"(cB), "+s"(nA), "+s"(nB));
            const char* a1 = cA + (size_t)(t + 1) * kstepA;
            const char* a2 = last ? nA : cA + (size_t)(t + 2) * kstepA; const char* b2 = last ? nB : cB + (size_t)(t + 2) * kstepB;
            const char* a3 = a2 + kstepA; const char* b3 = b2 + kstepB;
            if (last && has_next) S.a_ready(nxt);
            if constexpr (SP2) {
            PG8_LDB(B0, 0, 0); PG8_LDB(B1, 0, 1); PG8_SCHED; PG8_LDA(At, 0, 0); PG8_STAGE(PG8_SA(1, 1), a1 + hstepA, voffA);
            PG8_WAIT_V(8); PG8_WAIT_L(0); PG8_BAR; PG8_MMA(0, 0, At, B0); PG8_MMA(0, 1, At, B1); PG8_BAR; PG8_SCHED;
            PG8_LDA(At, 0, 1); PG8_STAGE(PG8_SB(0, 0), b2, voffB); PG8_STAGE(PG8_SB(0, 1), b2 + hstepB, voffB); PG8_STAGE(PG8_SA(0, 0), a2, voffA);
            PG8_WAIT_V(8); PG8_WAIT_L(0); PG8_BAR; PG8_MMA(1, 0, At, B0); PG8_MMA(1, 1, At, B1); PG8_BAR; PG8_SCHED;
            PG8_LDB(B0, 1, 0); PG8_LDB(B1, 1, 1); PG8_SCHED; PG8_LDA(At, 1, 0); PG8_STAGE(PG8_SA(0, 1), a2 + hstepA, voffA);
            PG8_WAIT_V(8); PG8_WAIT_L(0); PG8_BAR; PG8_MMA(0, 0, At, B0); PG8_MMA(0, 1, At, B1); PG8_BAR; PG8_SCHED;
            PG8_LDA(At, 1, 1); PG8_STAGE(PG8_SB(1, 0), b3, voffB); PG8_STAGE(PG8_SB(1, 1), b3 + hstepB, voffB); PG8_STAGE(PG8_SA(1, 0), a3, voffA);
            PG8_WAIT_V(8); PG8_WAIT_L(0); PG8_BAR; PG8_MMA(1, 0, At, B0); PG8_MMA(1, 1, At, B1); PG8_BAR; PG8_SCHED;
            } else {
            PG8_LDB(B0, 0, 0); PG8_SCHED; PG8_LDA(At, 0, 0); PG8_STAGE(PG8_SA(1, 1), a1 + hstepA, voffA);
            PG8_WAIT_L(8); PG8_BAR; PG8_WAIT_L(0); PG8_MMA(0, 0, At, B0); PG8_BAR; PG8_SCHED;
            PG8_LDB(B1, 0, 1); PG8_STAGE(PG8_SB(0, 0), b2, voffB);
            PG8_BAR; PG8_WAIT_L(0); PG8_MMA(0, 1, At, B1); PG8_BAR;
            PG8_LDA(At, 0, 1); PG8_STAGE(PG8_SA(0, 0), a2, voffA);
            PG8_BAR; PG8_WAIT_L(0); PG8_MMA(1, 0, At, B0); PG8_BAR; PG8_SCHED;
            PG8_STAGE(PG8_SB(0, 1), b2 + hstepB, voffB);
            PG8_WAIT_V(6); PG8_BAR; PG8_MMA(1, 1, At, B1); PG8_BAR;
            PG8_LDB(B0, 1, 0); PG8_SCHED; PG8_LDA(At, 1, 0); PG8_STAGE(PG8_SA(0, 1), a2 + hstepA, voffA);
            PG8_WAIT_L(8); PG8_BAR; PG8_WAIT_L(0); PG8_MMA(0, 0, At, B0); PG8_BAR; PG8_SCHED;
            PG8_LDB(B1, 1, 1); PG8_STAGE(PG8_SB(1, 0), b3, voffB);
            PG8_BAR; PG8_WAIT_L(0); PG8_MMA(0, 1, At, B1); PG8_BAR;
            PG8_LDA(At, 1, 1); PG8_STAGE(PG8_SA(1, 0), a3, voffA);
            PG8_BAR; PG8_WAIT_L(0); PG8_MMA(1, 0, At, B0); PG8_BAR; PG8_SCHED;
            PG8_STAGE(PG8_SB(1, 1), b3 + hstepB, voffB);
            PG8_WAIT_V(6); PG8_BAR; PG8_MMA(1, 1, At, B1); PG8_BAR;
            }
        }
        if constexpr (FP8) {
            asm volatile("s_nop 15\n\ts_nop 7" : "+v"(acc[0][0][0][0]), "+v"(acc[0][0][0][1]), "+v"(acc[0][0][1][0]), "+v"(acc[0][0][1][1]), "+v"(acc[0][0][2][0]), "+v"(acc[0][0][2][1]), "+v"(acc[0][0][3][0]), "+v"(acc[0][0][3][1]),
                         "+v"(acc[0][1][0][0]), "+v"(acc[0][1][0][1]), "+v"(acc[0][1][1][0]), "+v"(acc[0][1][1][1]), "+v"(acc[0][1][2][0]), "+v"(acc[0][1][2][1]), "+v"(acc[0][1][3][0]), "+v"(acc[0][1][3][1]));
            asm volatile("s_nop 0" : "+v"(acc[1][0][0][0]), "+v"(acc[1][0][0][1]), "+v"(acc[1][0][1][0]), "+v"(acc[1][0][1][1]), "+v"(acc[1][0][2][0]), "+v"(acc[1][0][2][1]), "+v"(acc[1][0][3][0]), "+v"(acc[1][0][3][1]),
                         "+v"(acc[1][1][0][0]), "+v"(acc[1][1][0][1]), "+v"(acc[1][1][1][0]), "+v"(acc[1][1][1][1]), "+v"(acc[1][1][2][0]), "+v"(acc[1][1][2][1]), "+v"(acc[1][1][3][0]), "+v"(acc[1][1][3][1])); }
        if constexpr (ALIGN_EPI) { if (wr == 0) PG8_BAR; }
        if constexpr (!Epi::AFTER_DRAIN) { E(acc, cur, wr, wc, fr, fq); S.done(cur); }
        if (!has_next) break;
        if (!Epi::keep_acc(cur)) {
#pragma unroll
        for (int a = 0; a < 2; ++a)
#pragma unroll
            for (int b = 0; b < 2; ++b)
#pragma unroll
                for (int m = 0; m < 4; ++m)
#pragma unroll
                    for (int n = 0; n < 2; ++n) acc[a][b][m][n] = (f32x4){0.f, 0.f, 0.f, 0.f};
        }
        cur = nxt; cA = nA; cB = nB; ++ui;
        if constexpr (ALIGN_EPI) { if (wr == 1) PG8_BAR; }
    }
    PG8_WAIT_V(0);
    if constexpr (!ALIGN_EPI) { if (wr == 0) PG8_BAR; }
    PG8_BAR;
    if constexpr (Epi::AFTER_DRAIN) { E.fused(acc, cur, wr, wc, fr, fq, lds, wid, lane); S.done(cur); }
#undef PG8_SA
#undef PG8_SB
#undef PG8_STAGE
#undef PG8_LDA
#undef PG8_LDB
#undef PG8_MMA
#undef PG8_CAT8
#undef PG8_WAIT_V
#undef PG8_WAIT_L
#undef PG8_BAR
#undef PG8_SCHED
}
}

namespace att {
#define SBAR() __builtin_amdgcn_sched_barrier(0)
constexpr int LDK = 1024;
constexpr int KVBLK = 64;
constexpr float SCALE = 0.125f;
constexpr float THR = 8.f;
constexpr float ACT_SCALE = 4.f;
constexpr int SHM_T = KVBLK * 128 * 2;
constexpr int LDS_V = 0, LDS_K = 2 * SHM_T, LDS_WS = 4 * SHM_T, LDS_OX = 0;
#define KSWZ(row, colB) ((row) * 256 + ((colB) ^ (((row) & 7) << 4)))
#define KSWZ64(row, colB) ((row) * 128 + ((colB) ^ (((row) & 7) << 4)))
__device__ __forceinline__ int crow(int r, int hi) { return (r & 3) + 8 * (r >> 2) + 4 * hi; }

__device__ __forceinline__ void partialSM(f32x16& p0, f32x16& p1, float& m_reg, float& mn, float& alpha) {
  constexpr float C = SCALE * 1.4426950408889634f;
  float pmax = p0[0];
#pragma unroll
  for (int r = 1; r < 16; ++r) pmax = fmaxf(pmax, p0[r]);
#pragma unroll
  for (int r = 0; r < 16; ++r) pmax = fmaxf(pmax, p1[r]);
  { auto rr = __builtin_amdgcn_permlane32_swap(__float_as_uint(pmax), __float_as_uint(pmax), false, false);
    pmax = fmaxf(__uint_as_float(rr[0]), __uint_as_float(rr[1])); }
  if (__builtin_expect(__all(pmax - m_reg <= THR / SCALE), 1)) { mn = m_reg; alpha = 1.f; }
  else { mn = fmaxf(m_reg, pmax); alpha = __builtin_amdgcn_exp2f((m_reg - mn) * C); m_reg = mn; }
  float mnC = -mn * C;
#pragma unroll
  for (int r = 0; r < 16; ++r) p0[r] = fmaf(p0[r], C, mnC);
#pragma unroll
  for (int r = 0; r < 16; ++r) p1[r] = fmaf(p1[r], C, mnC);
#pragma unroll
  for (int r = 0; r < 16; ++r) p0[r] = __builtin_amdgcn_exp2f(p0[r]);
}
#define PK4(P, BASE, OUT) do { unsigned a0 = cvt_pk_bf16(P[BASE + 0], P[BASE + 1]), a1 = cvt_pk_bf16(P[BASE + 2], P[BASE + 3]);   \
    unsigned b0 = cvt_pk_bf16(P[BASE + 4], P[BASE + 5]), b1 = cvt_pk_bf16(P[BASE + 6], P[BASE + 7]);                              \
    auto r0 = __builtin_amdgcn_permlane32_swap(a0, b0, false, false); auto r1 = __builtin_amdgcn_permlane32_swap(a1, b1, false, false); \
    u32x4 w = {r0[0], r1[0], r0[1], r1[1]}; OUT = __builtin_bit_cast(bf16x8, w); } while (0)
__device__ __forceinline__ void packP(const f32x16& p0, const f32x16& p1, bf16x8& pa0, bf16x8& pa1, bf16x8& pa2, bf16x8& pa3) {
  PK4(p0, 0, pa0); PK4(p0, 8, pa1); PK4(p1, 0, pa2); PK4(p1, 8, pa3);
}
__device__ __forceinline__ void finishSM(f32x16& p0, f32x16& p1, float alpha, float& l_reg, bf16x8& pa0, bf16x8& pa1, bf16x8& pa2, bf16x8& pa3) {
#pragma unroll
  for (int r = 0; r < 16; ++r) p1[r] = __builtin_amdgcn_exp2f(p1[r]);
  float ps = 0;
#pragma unroll
  for (int r = 0; r < 16; ++r) ps += p0[r];
#pragma unroll
  for (int r = 0; r < 16; ++r) ps += p1[r];
  { auto rr = __builtin_amdgcn_permlane32_swap(__float_as_uint(ps), __float_as_uint(ps), false, false);
    ps = __uint_as_float(rr[0]) + __uint_as_float(rr[1]); }
  l_reg = l_reg * alpha + ps;
  packP(p0, p1, pa0, pa1, pa2, pa3);
}
__device__ __forceinline__ void qkt(f32x16& p0, f32x16& p1, const char* Ks, const bf16x8* qr, int r32, int hi, int cb0) {
  p0 = f32x16{}; p1 = f32x16{};
#pragma unroll
  for (int d0 = 0; d0 < 4; ++d0) { int cb = cb0 + (d0 * 16 + hi * 8) * 2;
    bf16x8 b0 = *reinterpret_cast<const bf16x8*>(Ks + KSWZ(r32, cb));
    bf16x8 b1 = *reinterpret_cast<const bf16x8*>(Ks + KSWZ(32 + r32, cb));
    p0 = __builtin_amdgcn_mfma_f32_32x32x16_bf16(b0, qr[d0], p0, 0, 0, 0);
    p1 = __builtin_amdgcn_mfma_f32_32x32x16_bf16(b1, qr[d0], p1, 0, 0, 0); }
}
__device__ __forceinline__ int v_st(int k, int c) { const int kk = (k & ~0xC) | ((k & 4) << 1) | ((k & 8) >> 1); return ((kk >> 3) * 4 + (c >> 5)) * 512 + ((kk & 7) * 32 + (c & 31)) * 2; }
__device__ __forceinline__ int v_rd_base(int lane) { return ((lane & 3) << 3) | (((lane >> 2) & 3) << 6) | (((lane >> 4) & 1) << 5) | (((lane >> 5) & 1) << 8); }
template <int OFF> __device__ __forceinline__ s16x4 tr_read(int vb) {
  s16x4 r; asm volatile("ds_read_b64_tr_b16 %0, %1 offset:%2" : "=&v"(r) : "v"(vb), "i"(OFF) : "memory"); return r;
}
#define PKF(L, H) (bf16x8){L[0], L[1], L[2], L[3], H[0], H[1], H[2], H[3]}
__device__ __forceinline__ void pv_blk(f32x16& od, int vb, bf16x8 pa0, bf16x8 pa1, bf16x8 pa2, bf16x8 pa3) {
  const s16x4 l0 = tr_read<0>(vb), h0 = tr_read<2048>(vb), l1 = tr_read<4096>(vb), h1 = tr_read<4096 + 2048>(vb);
  const s16x4 l2 = tr_read<8192>(vb), h2 = tr_read<8192 + 2048>(vb), l3 = tr_read<12288>(vb), h3 = tr_read<12288 + 2048>(vb);
  asm volatile("s_waitcnt lgkmcnt(0)" ::: "memory"); SBAR();
  od = __builtin_amdgcn_mfma_f32_32x32x16_bf16(pa0, PKF(l0, h0), od, 0, 0, 0);
  od = __builtin_amdgcn_mfma_f32_32x32x16_bf16(pa1, PKF(l1, h1), od, 0, 0, 0);
  od = __builtin_amdgcn_mfma_f32_32x32x16_bf16(pa2, PKF(l2, h2), od, 0, 0, 0);
  od = __builtin_amdgcn_mfma_f32_32x32x16_bf16(pa3, PKF(l3, h3), od, 0, 0, 0);
}
__device__ __forceinline__ void pv_d0(f32x16* o, int vb, bf16x8 pa0, bf16x8 pa1, bf16x8 pa2, bf16x8 pa3) {
  pv_blk(o[0], vb, pa0, pa1, pa2, pa3); pv_blk(o[1], vb + 512, pa0, pa1, pa2, pa3); pv_blk(o[2], vb + 1024, pa0, pa1, pa2, pa3); pv_blk(o[3], vb + 1536, pa0, pa1, pa2, pa3);
}
__device__ __forceinline__ void tr_frag4(bf16x8* f, int vb) {
  const s16x4 l0 = tr_read<0>(vb), h0 = tr_read<2048>(vb), l1 = tr_read<4096>(vb), h1 = tr_read<4096 + 2048>(vb);
  const s16x4 l2 = tr_read<8192>(vb), h2 = tr_read<8192 + 2048>(vb), l3 = tr_read<12288>(vb), h3 = tr_read<12288 + 2048>(vb);
  asm volatile("s_waitcnt lgkmcnt(0)" ::: "memory"); SBAR();
  f[0] = PKF(l0, h0); f[1] = PKF(l1, h1); f[2] = PKF(l2, h2); f[3] = PKF(l3, h3);
}

template <int MODE>
__device__ __forceinline__ void combine_store(f32x16 (&o)[4], float lam, const float* gain, const bf16_t* zb, unsigned char* ob, char* lds) {
  int tidx = threadIdx.x; asm volatile("" : "+v"(tidx));
  const int wid = __builtin_amdgcn_readfirstlane(tidx >> 6), half = wid >> 2, w4 = wid & 3, r32 = tidx & 31, hi = (tidx >> 5) & 1;
  float* Ox = (float*)(lds + LDS_OX);
  u32x4 zv[4];
#pragma unroll
  for (int i = 0; i < 4; ++i) { const int id = tidx + 512 * i; zv[i] = *(const u32x4*)(zb + (size_t)(id >> 4) * LDK + (id & 15) * 8); }
  __syncthreads();
  if (half == 1) {
#pragma unroll
    for (int r = 0; r < 16; ++r) { const int row = w4 * 32 + crow(r, hi);
#pragma unroll
      for (int d0 = 0; d0 < 4; ++d0) Ox[row * 128 + d0 * 32 + r32] = o[d0][r]; }
  }
  __syncthreads();
  if (half == 0) {
    float gn[4];
#pragma unroll
    for (int d0 = 0; d0 < 4; ++d0) gn[d0] = gain[d0 * 32 + r32] * (MODE == 0 ? (1.f - LAM_INIT) : 1.f);
#pragma unroll
    for (int r = 0; r < 16; ++r) { const int row = w4 * 32 + crow(r, hi);
      float s1 = 0.f, s2 = 0.f; float v[4];
#pragma unroll
      for (int d0 = 0; d0 < 4; ++d0) { const float x = Ox[row * 128 + d0 * 32 + r32]; v[d0] = (MODE == 0) ? (o[d0][r] - lam * x) : (o[d0][r] + x); s1 += v[d0]; s2 += v[d0] * v[d0]; }
#pragma unroll
      for (int sh = 1; sh < 32; sh <<= 1) { s1 += __shfl_xor(s1, sh); s2 += __shfl_xor(s2, sh); }
      float mean, rstd;
      if (MODE == 0) { mean = 0.f; rstd = 1.0f / sqrtf(s2 * (1.f / 128.f) + LN_EPS); }
      else { mean = s1 * (1.f / 128.f); float var = s2 * (1.f / 128.f) - mean * mean; var = var < 0.f ? 0.f : var; rstd = 1.0f / sqrtf(var + LN_EPS); }
#pragma unroll
      for (int d0 = 0; d0 < 4; ++d0) Ox[row * 128 + d0 * 32 + r32] = (v[d0] - mean) * rstd * gn[d0];
    }
  }
  __syncthreads();
#pragma unroll
  for (int i = 0; i < 4; ++i) { const int id = tidx + 512 * i, row = id >> 4, q = id & 15;
    const f32x4 a = *(const f32x4*)(Ox + row * 128 + q * 8), b = *(const f32x4*)(Ox + row * 128 + q * 8 + 4);
    u32x2 w; w.x = cvt4_fp8(a[0] * bf_lo(zv[i].x) * ACT_SCALE, a[1] * bf_hi(zv[i].x) * ACT_SCALE, a[2] * bf_lo(zv[i].y) * ACT_SCALE, a[3] * bf_hi(zv[i].y) * ACT_SCALE);
    w.y = cvt4_fp8(b[0] * bf_lo(zv[i].z) * ACT_SCALE, b[1] * bf_hi(zv[i].z) * ACT_SCALE, b[2] * bf_lo(zv[i].w) * ACT_SCALE, b[3] * bf_hi(zv[i].w) * ACT_SCALE);
    *(u32x2*)(ob + (size_t)row * (LDK * 2) + q * 8) = w; }
  __syncthreads();
}

__device__ __forceinline__ void attn_unit(const bf16_t* Qb, const bf16_t* Kh, const bf16_t* Vh, int seq, float lam, const float* subg, const bf16_t* zb, unsigned char* ob, char* lds) {
  const int tid = threadIdx.x, wid = __builtin_amdgcn_readfirstlane(tid >> 6), lane = tid & 63, r32 = lane & 31, hi = lane >> 5, map = wid >> 2, w4 = wid & 3;
  char* V_lds = lds + LDS_V; char* K_lds = lds + LDS_K;
  float* ws = (float*)(lds + LDS_WS) + wid * 64; float* li_l = ws; float* al_l = ws + 32;
  float m_reg = -1e30f, l_reg = 0; f32x16 o[4] = {}; bf16x8 qr[4];
  const bf16_t* Qw = Qb + (size_t)(w4 * 32 + r32) * LDK + map * 64 + hi * 8;
#pragma unroll
  for (int d0 = 0; d0 < 4; ++d0) qr[d0] = *reinterpret_cast<const bf16x8*>(Qw + d0 * 16);
  const int cb0 = map * 128;
  const int sr = tid >> 4, sc = (tid & 15) * 8, vst0 = v_st(sr, sc), vst1 = v_st(32 + sr, sc);
  const int vb0 = (int)(uintptr_t)V_lds + v_rd_base(lane);
  struct { bf16x8 vs0, vs1, ks0, ks1; } sr_[2];
#define SLOAD(i, k0) do { sr_[i].vs0 = *(const bf16x8*)(&Vh[(size_t)((k0) + sr) * LDK + sc]); sr_[i].vs1 = *(const bf16x8*)(&Vh[(size_t)((k0) + 32 + sr) * LDK + sc]); \
    sr_[i].ks0 = *(const bf16x8*)(&Kh[(size_t)((k0) + sr) * LDK + sc]); sr_[i].ks1 = *(const bf16x8*)(&Kh[(size_t)((k0) + 32 + sr) * LDK + sc]); } while (0)
#define SWRITE(b, i) do { *(bf16x8*)(V_lds + (b) * SHM_T + vst0) = sr_[i].vs0;          \
    *(bf16x8*)(V_lds + (b) * SHM_T + vst1) = sr_[i].vs1; int kc = sc * 2;               \
    *(bf16x8*)(K_lds + (b) * SHM_T + KSWZ(sr, kc)) = sr_[i].ks0;                       \
    *(bf16x8*)(K_lds + (b) * SHM_T + KSWZ(32 + sr, kc)) = sr_[i].ks1; } while (0)
#define SWAIT() asm volatile("s_waitcnt vmcnt(4)" ::: "memory")
#define RESC(a) do { if (__any((a) < 1.f)) { if (hi == 0) al_l[r32] = (a); asm volatile("s_waitcnt lgkmcnt(0)" ::: "memory"); \
    _Pragma("unroll") for (int d = 0; d < 4; ++d) _Pragma("unroll") for (int r = 0; r < 16; ++r) o[d][r] *= al_l[crow(r, hi)]; } } while (0)
  f32x16 pA0, pA1, pB0, pB1; float mnA, mnB, alA, alB; bf16x8 pa0, pa1, pa2, pa3; const int NT = seq / KVBLK;
  constexpr int SE = 0, SO = 1;
  SLOAD(SE, 0); asm volatile("s_waitcnt vmcnt(0)" ::: "memory"); SWRITE(0, SE); __syncthreads();
  qkt(pA0, pA1, K_lds, qr, r32, hi, cb0); partialSM(pA0, pA1, m_reg, mnA, alA);
  SLOAD(SO, KVBLK); if (2 < NT) SLOAD(SE, 2 * KVBLK);
  SWAIT(); SWRITE(1, SO); __syncthreads();
  for (int j = 1; j + 1 < NT; j += 2) {
    SBAR(); qkt(pB0, pB1, K_lds + SHM_T, qr, r32, hi, cb0);
    finishSM(pA0, pA1, alA, l_reg, pa0, pa1, pa2, pa3); SBAR();
    SLOAD(SO, (j + 2) * KVBLK); SBAR();
    pv_d0(o, vb0, pa0, pa1, pa2, pa3); partialSM(pB0, pB1, m_reg, mnB, alB);
    __syncthreads(); SWAIT(); SWRITE(0, SE);
    RESC(alB); __syncthreads();
    SBAR(); qkt(pA0, pA1, K_lds, qr, r32, hi, cb0);
    finishSM(pB0, pB1, alB, l_reg, pa0, pa1, pa2, pa3); SBAR();
    if (j + 3 < NT) SLOAD(SE, (j + 3) * KVBLK); SBAR();
    pv_d0(o, vb0 + SHM_T, pa0, pa1, pa2, pa3); partialSM(pA0, pA1, m_reg, mnA, alA);
    __syncthreads(); SWAIT(); SWRITE(1, SO);
    RESC(alA); __syncthreads();
  }
  SBAR(); qkt(pB0, pB1, K_lds + SHM_T, qr, r32, hi, cb0);
  finishSM(pA0, pA1, alA, l_reg, pa0, pa1, pa2, pa3); SBAR();
  pv_d0(o, vb0, pa0, pa1, pa2, pa3); partialSM(pB0, pB1, m_reg, mnB, alB);
  __syncthreads(); RESC(alB);
  finishSM(pB0, pB1, alB, l_reg, pa0, pa1, pa2, pa3); SBAR();
  pv_d0(o, vb0 + SHM_T, pa0, pa1, pa2, pa3);
  if (hi == 0) li_l[r32] = l_reg; asm volatile("s_waitcnt lgkmcnt(0)" ::: "memory");
#pragma unroll
  for (int r = 0; r < 16; ++r) { const float rl = __builtin_amdgcn_rcpf(li_l[crow(r, hi)]);
#pragma unroll
    for (int d0 = 0; d0 < 4; ++d0) o[d0][r] *= rl; }
  combine_store<0>(o, lam, subg, zb, ob, lds);
#undef SLOAD
#undef SWRITE
#undef SWAIT
#undef RESC
}

__device__ __forceinline__ bf16x8 scale8(bf16x8 x, float s) {
  const u32x4 w = __builtin_bit_cast(u32x4, x); u32x4 o;
  o.x = cvt_pk_bf16(bf_lo(w.x) * s, bf_hi(w.x) * s); o.y = cvt_pk_bf16(bf_lo(w.y) * s, bf_hi(w.y) * s);
  o.z = cvt_pk_bf16(bf_lo(w.z) * s, bf_hi(w.z) * s); o.w = cvt_pk_bf16(bf_lo(w.w) * s, bf_hi(w.w) * s);
  return __builtin_bit_cast(bf16x8, o);
}

__device__ __forceinline__ void ret_local_unit(const bf16_t* Kp, const bf16_t* Vp, float l2f, float l2b, float* Lout, char* lds) {
  const int tid = threadIdx.x, wid = __builtin_amdgcn_readfirstlane(tid >> 6), lane = tid & 63, r32 = lane & 31, hi = lane >> 5;
  char* Kimg = lds; char* Vimg = lds + 2 * SHM_T;
  const int sr = tid >> 4, sc = (tid & 15) * 8, dir = sc >> 6, kc = sc & 63;
  bf16x8 vv[4], kk[4];
#pragma unroll
  for (int q = 0; q < 4; ++q) { const int j = 64 * (q >> 1) + sr + 32 * (q & 1);
    vv[q] = *(const bf16x8*)(Vp + (size_t)j * 1024 + sc); kk[q] = *(const bf16x8*)(Kp + (size_t)j * 512 + kc); }
#pragma unroll
  for (int q = 0; q < 4; ++q) { const int t = q >> 1, row = sr + 32 * (q & 1), j = 64 * t + row;
    const float dec = dir == 0 ? __builtin_amdgcn_exp2f(l2f * (float)(127 - j)) : __builtin_amdgcn_exp2f(l2b * (float)j);
    *(bf16x8*)(Vimg + t * SHM_T + v_st(row, sc)) = vv[q];
    *(bf16x8*)(Kimg + t * SHM_T + v_st(row, sc)) = scale8(kk[q], dec); }
  __syncthreads();
  const int ra = wid >> 1, cb = (wid & 1) * 2;
  const int vrd = v_rd_base(lane);
  f32x16 acc0 = {}, acc1 = {};
#pragma unroll
  for (int t = 0; t < 2; ++t) {
    bf16x8 af[4]; tr_frag4(af, (int)(uintptr_t)(Kimg + t * SHM_T) + vrd + 512 * ra);
    pv_blk(acc0, (int)(uintptr_t)(Vimg + t * SHM_T) + vrd + 512 * cb, af[0], af[1], af[2], af[3]);
    pv_blk(acc1, (int)(uintptr_t)(Vimg + t * SHM_T) + vrd + 512 * (cb + 1), af[0], af[1], af[2], af[3]);
  }
  float* Lo = Lout + (size_t)((ra >> 1) * 64 + 32 * (ra & 1)) * 128 + 32 * cb + r32;
#pragma unroll
  for (int r = 0; r < 16; ++r) { Lo[crow(r, hi) * 128] = acc0[r]; Lo[crow(r, hi) * 128 + 32] = acc1[r]; }
  __syncthreads();
}

__device__ __forceinline__ void ret_out_unit(const bf16_t* Qp, const bf16_t* Kp, const bf16_t* Vp, const bf16_t* Pf, const bf16_t* Pb, float l2f, float l2b,
                                             const float* gain, const bf16_t* zb, unsigned char* ob, char* lds) {
  const int tid = threadIdx.x, wid = __builtin_amdgcn_readfirstlane(tid >> 6), lane = tid & 63, r32 = lane & 31, hi = lane >> 5, qblk = wid & 3, kt = wid >> 2;
  char* Kimg = lds; char* Vimg = lds + SHM_T; char* Pimg = lds + 3 * SHM_T;
  const int i = 32 * qblk + r32;
  bf16x8 qr[4];
  { const int row = tid >> 3, c8 = (tid & 7) * 8, sr = tid >> 4, sc = (tid & 15) * 8;
    bf16x8 kk[2], vv[4], pp[4];
#pragma unroll
    for (int rr = 0; rr < 2; ++rr) kk[rr] = *(const bf16x8*)(Kp + (size_t)(row + 64 * rr) * 512 + c8);
#pragma unroll
    for (int q = 0; q < 4; ++q) { const int t = q >> 1, rw = sr + 32 * (q & 1);
      vv[q] = *(const bf16x8*)(Vp + (size_t)(64 * t + rw) * 1024 + sc); pp[q] = *(const bf16x8*)((t == 0 ? Pf : Pb) + rw * 128 + sc); }
#pragma unroll
    for (int d0 = 0; d0 < 4; ++d0) qr[d0] = *(const bf16x8*)(Qp + (size_t)i * 512 + d0 * 16 + hi * 8);
#pragma unroll
    for (int rr = 0; rr < 2; ++rr) *(bf16x8*)(Kimg + KSWZ64(row + 64 * rr, c8 * 2)) = kk[rr];
#pragma unroll
    for (int q = 0; q < 4; ++q) { const int t = q >> 1, rw = sr + 32 * (q & 1);
      *(bf16x8*)(Vimg + t * SHM_T + v_st(rw, sc)) = vv[q]; *(bf16x8*)(Pimg + t * SHM_T + v_st(rw, sc)) = pp[q]; } }
  __syncthreads();
  f32x16 p0 = {}, p1 = {};
#pragma unroll
  for (int d0 = 0; d0 < 4; ++d0) { const int cb = (d0 * 16 + hi * 8) * 2;
    const bf16x8 b0 = *(const bf16x8*)(Kimg + KSWZ64(64 * kt + r32, cb));
    const bf16x8 b1 = *(const bf16x8*)(Kimg + KSWZ64(64 * kt + 32 + r32, cb));
    p0 = __builtin_amdgcn_mfma_f32_32x32x16_bf16(b0, qr[d0], p0, 0, 0, 0);
    p1 = __builtin_amdgcn_mfma_f32_32x32x16_bf16(b1, qr[d0], p1, 0, 0, 0); }
#pragma unroll
  for (int r = 0; r < 16; ++r) { const int j0 = 64 * kt + crow(r, hi); const int d0 = i - j0, d1 = d0 - 32;
    const float w0 = d0 > 0 ? __builtin_amdgcn_exp2f(l2f * (float)d0) : (d0 < 0 ? __builtin_amdgcn_exp2f(l2b * (float)(-d0)) : 2.f);
    const float w1 = d1 > 0 ? __builtin_amdgcn_exp2f(l2f * (float)d1) : (d1 < 0 ? __builtin_amdgcn_exp2f(l2b * (float)(-d1)) : 2.f);
    p0[r] *= w0; p1[r] *= w1; }
  bf16x8 pa0, pa1, pa2, pa3; packP(p0, p1, pa0, pa1, pa2, pa3);
  f32x16 o[4] = {};
  const int vrd = v_rd_base(lane);
  pv_d0(o, (int)(uintptr_t)(Vimg + kt * SHM_T) + vrd, pa0, pa1, pa2, pa3);
  const float qs = kt == 0 ? __builtin_amdgcn_exp2f(l2f * (float)(i + 1)) : __builtin_amdgcn_exp2f(l2b * (float)(128 - i));
  pv_d0(o, (int)(uintptr_t)(Pimg + kt * SHM_T) + vrd, scale8(qr[0], qs), scale8(qr[1], qs), scale8(qr[2], qs), scale8(qr[3], qs));
  combine_store<1>(o, 0.f, gain, zb, ob, lds);
}
#undef SBAR
}
typedef GAS unsigned gu32;
typedef GAS unsigned long long gu64;
#define RLX_AGENT __ATOMIC_RELAXED, __HIP_MEMORY_SCOPE_AGENT
#define LDS_WAIT() asm volatile("s_waitcnt lgkmcnt(0)" ::: "memory")
#define VM_WAIT() asm volatile("s_waitcnt vmcnt(0)" ::: "memory")

#define XB_TMO      128
#define XB_XCNT(j)  (256  + 64 * (j))
#define XB_XSUB(j)  (1280 + 64 * (j))
#define XB_XGEN(j)  (2304 + 64 * (j))
#define XB_TOP      3328
#define XB_TOPGEN   3392
#define XCD_BAR_WORDS 3456
#define XB_SPIN_CAP (1u << 18)

__device__ __forceinline__ unsigned xb_ld(unsigned* p)              { return __hip_atomic_load(p, __ATOMIC_RELAXED, __HIP_MEMORY_SCOPE_AGENT); }
__device__ __forceinline__ unsigned xb_add(unsigned* p, unsigned v) { return __hip_atomic_fetch_add(p, v, __ATOMIC_RELAXED, __HIP_MEMORY_SCOPE_AGENT); }
__device__ __forceinline__ unsigned xb_xcc_id() { return (unsigned)__builtin_amdgcn_s_getreg((3 << 11) | 20) & 0xFu; }
#define XB_SPIN(cond, bar) do { unsigned _sp = 0; while (cond) { __builtin_amdgcn_s_sleep(1); \
    if ((++_sp & 255u) == 0u) { if (xb_ld(&(bar)[XB_TMO])) break; if (_sp > XB_SPIN_CAP) { atomicAdd(&(bar)[XB_TMO], 1u); break; } } } } while (0)

struct XcdBarrier {
    unsigned* bar; unsigned x;
    volatile LAS unsigned* st;
};

__device__ __forceinline__ XcdBarrier xcd_barrier_post(unsigned* bar, volatile LAS unsigned* st) {
    XcdBarrier b; b.bar = bar; b.x = xb_xcc_id(); b.st = st;
    if (threadIdx.x == 0) (void)xb_add(&bar[XB_XCNT(b.x)], 1u);
    return b;
}
__device__ __forceinline__ void xcd_barrier_complete(unsigned* bar, unsigned x, unsigned& nloc, unsigned& nx) {
    const unsigned G = gridDim.x * gridDim.y * gridDim.z;
    unsigned sum, cnt, mine, sp = 0u;
    for (;;) {
        sum = 0u; cnt = 0u; mine = 0u;
#pragma unroll
        for (unsigned j = 0; j < 16; ++j) { const unsigned c = xb_ld(&bar[XB_XCNT(j)]); sum += c; cnt += (c > 0u) ? 1u : 0u; mine = (j == x) ? c : mine; }
        if (sum == G) break;
        __builtin_amdgcn_s_sleep(1);
        if ((++sp & 255u) == 0u) { if (xb_ld(&bar[XB_TMO])) break; if (sp > XB_SPIN_CAP) { atomicAdd(&bar[XB_TMO], 1u); break; } }
    }
    nloc = mine > 0u ? mine : 1u; nx = cnt > 0u ? cnt : 1u;
}

__device__ __forceinline__ void xcd_barrier(const XcdBarrier& b) {
    asm volatile("s_waitcnt vmcnt(0)" ::: "memory");
    __syncthreads();
    if (threadIdx.x == 0) {
        unsigned* bar = b.bar;
        __builtin_amdgcn_s_waitcnt(0);
        unsigned nloc = b.st[0], nx = b.st[1];
        if (nloc == 0u) { xcd_barrier_complete(bar, b.x, nloc, nx); b.st[0] = nloc; b.st[1] = nx; }
        const unsigned old = xb_add(&bar[XB_XSUB(b.x)], 1u);
        const unsigned gen = old / nloc;
        if (old + 1u == (gen + 1u) * nloc) {
            __builtin_amdgcn_fence(__ATOMIC_RELEASE, "agent");
            asm volatile("s_waitcnt vmcnt(0)" ::: "memory");
            const unsigned og = xb_add(&bar[XB_TOP], 1u);
            const unsigned tg = og / nx;
            if (og + 1u == (tg + 1u) * nx) xb_add(&bar[XB_TOPGEN], 1u);
            else XB_SPIN(xb_ld(&bar[XB_TOPGEN]) == tg, bar);
            __builtin_amdgcn_fence(__ATOMIC_ACQUIRE, "agent");
            xb_add(&bar[XB_XGEN(b.x)], 1u);
            asm volatile("s_waitcnt vmcnt(0)" ::: "memory");
        } else {
            XB_SPIN(xb_ld(&bar[XB_XGEN(b.x)]) == gen, bar);
            __builtin_amdgcn_fence(__ATOMIC_ACQUIRE, "agent");
            asm volatile("s_waitcnt vmcnt(0)" ::: "memory");
        }
    }
    __syncthreads();
}

#ifndef MK_N_LAUNCHES
#define MK_N_LAUNCHES 1
#endif
#ifndef REP_P0A
#define REP_P0A 1
#endif
#ifndef REP_P0B
#define REP_P0B 1
#endif
#ifndef REP_P1
#define REP_P1 1
#endif
#ifndef REP_P2A
#define REP_P2A 1
#endif
#ifndef REP_P2B
#define REP_P2B 1
#endif
#ifndef REP_P3
#define REP_P3 1
#endif
#ifndef REP_P4
#define REP_P4 1
#endif
#ifndef REP_P5
#define REP_P5 1
#endif
#ifndef REP_P6
#define REP_P6 1
#endif
#ifndef REP_P7
#define REP_P7 1
#endif
#define REPEAT(n) for (int rep_ = 0; rep_ < (n); ++rep_)
constexpr int N_PHASES = 9;
constexpr int NWAVES = 8;
constexpr size_t MiB = 1u << 20;
constexpr size_t WS_CTL = 0, CTL_ZERO_BYTES = 64 * 1024;
constexpr size_t WS_W8CAT = 2 * MiB;
constexpr size_t WS_WKV = 11 * MiB;
constexpr size_t WS_W8PA = 18 * MiB, WS_W8PR = 19 * MiB, WS_W8OUT = 20 * MiB;
constexpr size_t WS_QA = 26 * MiB;
constexpr size_t WS_ZA = 50 * MiB;
constexpr size_t WS_QR = 74 * MiB, WS_KR = 86 * MiB;
constexpr size_t WS_VR = 98 * MiB;
constexpr size_t WS_ZR = 122 * MiB;
constexpr size_t WS_G = 146 * MiB;
constexpr size_t WS_KC = 194 * MiB, WS_VC = 202 * MiB;
constexpr size_t WS_KL = 210 * MiB, WS_VL = 228 * MiB;
constexpr size_t WS_PST = 194 * MiB;
constexpr size_t WS_MODP = 246 * MiB;
constexpr size_t WS_MODF = 247 * MiB;
constexpr size_t WS_ROPE = 247 * MiB + 64 * 1024;
constexpr size_t WS_MISC = 247 * MiB + 128 * 1024;
constexpr size_t WS_STATS = 248 * MiB;
constexpr size_t WS_END = 249 * MiB;
static_assert(WS_W8CAT + (size_t)N_CAT * DM <= WS_WKV && WS_WKV + (size_t)3584 * DM * 2 <= WS_W8PA && WS_VL + (size_t)LAT_B * LAT_KEYS * 1024 * 2 <= WS_MODP && WS_PST + (size_t)768 * 2 * 8192 * 2 <= WS_MODP, "d_ws map");
constexpr size_t OUT_Y = 0, OUT_K = 12582912, OUT_V = 16777216, OUT_SF = 20971520, OUT_SB = 22020096, OUT_END = 23068672;
constexpr int CW_BAR = 1024;
constexpr int RING_BYTES = 131072, LDSCTL_OFF = RING_BYTES, MISC_OFF = LDSCTL_OFF + 320, LDS_BYTES = 147456;

__device__ __forceinline__ float wave_sum(float v) {
#pragma unroll
    for (int o = 1; o < 64; o <<= 1) v += __shfl_xor(v, o);
    return v;
}
__device__ __forceinline__ void p0_transpose_item(const float* W, int K, int ncols, int ldw, bf16_t* WT, int row_off, LAS float* scr, int item, int lane) {
    const int nblk = ncols / 32, kb = item / nblk, nb = item % nblk, k0 = 64 * kb, n0 = 32 * nb;
#pragma unroll 8
    for (int i = 0; i < 32; ++i) { const int kk = 2 * i + (lane >> 5); scr[kk * 33 + (lane & 31)] = W[(size_t)(k0 + kk) * ldw + n0 + (lane & 31)]; }
    LDS_WAIT(); asm volatile("" ::: "memory");
    const int c = lane & 7;
#pragma unroll
    for (int j = 0; j < 4; ++j) { const int n = (lane >> 3) + 8 * j; const LAS float* s = scr + (8 * c) * 33 + n;
        u32x4 o; o.x = cvt_pk_bf16(s[0 * 33], s[1 * 33]); o.y = cvt_pk_bf16(s[2 * 33], s[3 * 33]); o.z = cvt_pk_bf16(s[4 * 33], s[5 * 33]); o.w = cvt_pk_bf16(s[6 * 33], s[7 * 33]);
        *(u32x4*)(WT + (size_t)(row_off + n0 + n) * K + k0 + 8 * c) = o; }
    LDS_WAIT(); asm volatile("" ::: "memory");
}
__device__ __forceinline__ void p0_transpose8_item(const float* W, int K, int ncols, int ldw, unsigned char* W8, int row_off, float scale, LAS float* scr, int item, int lane) {
    const int nblk = ncols / 32, kb = item / nblk, nb = item % nblk, k0 = 64 * kb, n0 = 32 * nb;
#pragma unroll 8
    for (int i = 0; i < 32; ++i) { const int kk = 2 * i + (lane >> 5); scr[kk * 33 + (lane & 31)] = W[(size_t)(k0 + kk) * ldw + n0 + (lane & 31)] * scale; }
    LDS_WAIT(); asm volatile("" ::: "memory");
    const int n = lane >> 1;
#pragma unroll
    for (int j = 0; j < 2; ++j) { const int c = (lane & 1) + 2 * j; const LAS float* s = scr + (16 * c) * 33 + n;
        u32x4 o; o.x = cvt4_fp8(s[0 * 33], s[1 * 33], s[2 * 33], s[3 * 33]); o.y = cvt4_fp8(s[4 * 33], s[5 * 33], s[6 * 33], s[7 * 33]);
        o.z = cvt4_fp8(s[8 * 33], s[9 * 33], s[10 * 33], s[11 * 33]); o.w = cvt4_fp8(s[12 * 33], s[13 * 33], s[14 * 33], s[15 * 33]);
        *(u32x4*)(W8 + (size_t)(row_off + n0 + n) * K + k0 + 16 * c) = o; }
    LDS_WAIT(); asm volatile("" ::: "memory");
}
__device__ __forceinline__ void sincos_d(double a, double& s, double& c) {
    const double TWO_PI = 6.283185307179586476925286766559;
    const double n = __builtin_rint(a / TWO_PI); const double x = a - n * TWO_PI, x2 = x * x;
    double ts = 1.0, tc = 1.0, ss = 1.0, cc = 1.0;
#pragma unroll
    for (int k = 1; k <= 14; ++k) { tc *= -x2 / (double)((2 * k - 1) * (2 * k)); ts *= -x2 / (double)((2 * k) * (2 * k + 1)); cc += tc; ss += ts; }
    s = x * ss; c = cc;
}
__device__ __forceinline__ float log2_gamma(float rd) { return log1pf(-exp2f(rd)) * 1.4426950408889634f; }

struct Args { const float* in[22]; float* out; unsigned char* ws; int ph_lo, ph_hi; };

__global__ void __launch_bounds__(NWAVES * 64, 2) mk_fwd(Args args) {
    extern __shared__ __attribute__((aligned(16))) unsigned char lds[];
    LAS unsigned char* ldsl = (LAS unsigned char*)lds;
    const int tid = threadIdx.x, lane = tid & 63, wave = __builtin_amdgcn_readfirstlane(tid >> 6);
    const int G = gridDim.x; const int bx = blockIdx.x; const int vcu = (G % 8 == 0) ? (bx % 8) * (G / 8) + bx / 8 : bx;
    unsigned char* ws = args.ws; float* dout = args.out;
    gu32* ctl = (gu32*)(ws + WS_CTL);
    volatile LAS unsigned* MISC = (volatile LAS unsigned*)(ldsl + MISC_OFF);
    for (int u = tid; u < (LDS_BYTES - LDSCTL_OFF) / 4; u += NWAVES * 64) ((LAS unsigned*)(ldsl + LDSCTL_OFF))[u] = 0u;
    __syncthreads();
    const int lo = args.ph_lo, hi = args.ph_hi;
    XcdBarrier bar; bar.bar = (unsigned*)(ctl + CW_BAR); bar.x = 0; bar.st = nullptr;
    if (hi - lo > 1) bar = xcd_barrier_post((unsigned*)(ctl + CW_BAR), MISC + 8);
#ifndef PHASE_MASK
#define PHASE_MASK 0x1ff
#endif
#define IN(k) (((PHASE_MASK >> (k)) & 1) && lo <= (k) && (k) < hi)
#define SEAM(k) do { if (IN(k) && IN((k) + 1)) xcd_barrier(bar); } while (0)
    const float* x_prompt = args.in[0]; const float* x_sample = args.in[1]; const float* cache_k = args.in[2]; const float* cache_v = args.in[3];
    const float* st_f = args.in[4]; const float* st_b = args.in[5]; const float* c_lat = args.in[6]; const float* c_ctx = args.in[7];
    const float* w_mod = args.in[8]; const float* b_mod = args.in[9]; const float* w_in = args.in[10]; const float* lam_p = args.in[11];
    const float* subln_g = args.in[12]; const float* ret_decay = args.in[13]; const float* ret_gn_g = args.in[14];
    const float* w_pa = args.in[15]; const float* w_pr = args.in[16]; const float* w_gate = args.in[17]; const float* b_gate = args.in[18];
    const float* w_out = args.in[19]; const float* ln_g = args.in[20]; const float* ln_b = args.in[21];
    unsigned char* W8CAT = ws + WS_W8CAT; bf16_t* WKV = (bf16_t*)(ws + WS_WKV); unsigned char* W8PA = ws + WS_W8PA; unsigned char* W8PR = ws + WS_W8PR; unsigned char* W8OUT = ws + WS_W8OUT;
    bf16_t* QA = (bf16_t*)(ws + WS_QA); bf16_t* ZA = (bf16_t*)(ws + WS_ZA); bf16_t* QR = (bf16_t*)(ws + WS_QR); bf16_t* KR = (bf16_t*)(ws + WS_KR);
    bf16_t* VR = (bf16_t*)(ws + WS_VR); bf16_t* ZR = (bf16_t*)(ws + WS_ZR); bf16_t* GT = (bf16_t*)(ws + WS_G);
    bf16_t* KC = (bf16_t*)(ws + WS_KC); bf16_t* VC = (bf16_t*)(ws + WS_VC); bf16_t* KL = (bf16_t*)(ws + WS_KL); bf16_t* VL = (bf16_t*)(ws + WS_VL);
    bf16_t* PST = (bf16_t*)(ws + WS_PST);
    float* MODP = (float*)(ws + WS_MODP); float* MODF = (float*)(ws + WS_MODF); float* ROPE = (float*)(ws + WS_ROPE); float* MISCW = (float*)(ws + WS_MISC); float* STATS = (float*)(ws + WS_STATS);
    unsigned char* H8 = (unsigned char*)dout;
    bf16_t* HCTX = (bf16_t*)((unsigned char*)dout + 12 * MiB);
    unsigned char* M8 = ws + WS_ZA;
    float* LST = dout;
    const int gw = vcu * NWAVES + wave, NGW = G * NWAVES;
    const int gt = bx * (NWAVES * 64) + tid, NGT = G * NWAVES * 64;

    if (IN(0)) REPEAT(REP_P0A) {
        LAS float* scr = (LAS float*)(ldsl + wave * 16384);
        constexpr int I_MOD = 192, I_IN = 16 * (N_IN / 32), I_GT = 16 * (N_GATE / 32), I_SQ = 16 * 32, I_KA = 16 * (2048 / 32), I_KR = 16 * (1536 / 32);
        constexpr int NITEMS = I_MOD + I_IN + I_GT + 3 * I_SQ + I_KA + I_KR;
        for (int it = gw; it < NITEMS; it += NGW) {
            int r = it;
            if (r < I_MOD) {
                const int cg = r % 12, ks = r / 12;
                float sv[5];
                { const int k = 64 * ks + lane; sv[0] = silu_f(c_ctx[k]);
#pragma unroll
                  for (int j = 1; j < 5; ++j) sv[j] = silu_f(c_lat[(j - 1) * DM + k]); }
                f32x4 a[5];
#pragma unroll
                for (int j = 0; j < 5; ++j) a[j] = (f32x4){0.f, 0.f, 0.f, 0.f};
                const float* wp = w_mod + (size_t)(64 * ks) * 3072 + 256 * cg + 4 * lane;
#pragma unroll 8
                for (int kk = 0; kk < 64; ++kk) { const f32x4 w = *(const f32x4*)(wp + (size_t)kk * 3072);
#pragma unroll
                    for (int j = 0; j < 5; ++j) a[j] += w * __shfl(sv[j], kk); }
#pragma unroll
                for (int j = 0; j < 5; ++j) *(f32x4*)(MODP + ((size_t)ks * 5 + j) * 3072 + 256 * cg + 4 * lane) = a[j];
                continue; }
            r -= I_MOD;
            if (r < I_IN) { p0_transpose8_item(w_in, DM, N_IN, N_IN, W8CAT, 0, 32.f, scr, r, lane); continue; } r -= I_IN;
            if (r < I_GT) { p0_transpose8_item(w_gate, DM, N_GATE, N_GATE, W8CAT, N_IN, 32.f, scr, r, lane); continue; } r -= I_GT;
            if (r < I_SQ) { p0_transpose8_item(w_pa, DM, DM, DM, W8PA, 0, 64.f, scr, r, lane); continue; } r -= I_SQ;
            if (r < I_SQ) { p0_transpose8_item(w_pr, DM, DM, DM, W8PR, 0, 64.f, scr, r, lane); continue; } r -= I_SQ;
            if (r < I_SQ) { p0_transpose8_item(w_out, DM, DM, DM, W8OUT, 0, 64.f, scr, r, lane); continue; } r -= I_SQ;
            if (r < I_KA) { p0_transpose_item(w_in + 1024, DM, 2048, N_IN, WKV, 0, scr, r, lane); continue; } r -= I_KA;
            p0_transpose_item(w_in + 4608, DM, 1536, N_IN, WKV, 2048, scr, r, lane);
        }
        for (int i = gt; i < 2 * LAT_B * PAST * 128; i += NGT) {
            const int which = i / (LAT_B * PAST * 128), j = i % (LAT_B * PAST * 128), b = j / (PAST * 128), e = (j % (PAST * 128)) * 8;
            const float* src = (which ? cache_v : cache_k) + (size_t)b * PAST * 1024 + e;
            const f32x4 a = *(const f32x4*)src, c = *(const f32x4*)(src + 4);
            u32x4 w; w.x = cvt_pk_bf16(a[0], a[1]); w.y = cvt_pk_bf16(a[2], a[3]); w.z = cvt_pk_bf16(c[0], c[1]); w.w = cvt_pk_bf16(c[2], c[3]);
            *(u32x4*)((which ? VL : KL) + (size_t)b * LAT_KEYS * 1024 + e) = w;
        }
        if (gt < 1024) {
            const int p = gt >> 4, f = gt & 15;
            const float inv = exp2f(-(float)f * (13.287712379549449f / 16.0f));
            const float ang = (float)p * inv; double s, c; sincos_d((double)ang, s, c);
            ROPE[gt * 2] = (float)c; ROPE[gt * 2 + 1] = (float)s;
        }
        if (gt == 0) { float s1 = 0.f, s2 = 0.f; for (int i = 0; i < 64; ++i) { s1 += lam_p[i] * lam_p[64 + i]; s2 += lam_p[128 + i] * lam_p[192 + i]; }
            MISCW[0] = expf(s1) - expf(s2) + LAM_INIT; }
    }
    SEAM(0);

    if (IN(1)) REPEAT(REP_P0B) {
        LAS float* SS = (LAS float*)ldsl;
        const int rows_per = (MTOK + G - 1) / G, r0 = bx * rows_per, r1 = (r0 + rows_per < MTOK) ? r0 + rows_per : MTOK;
        if (r0 < MTOK) {
            const int mb0 = r0 < M_CTX ? 0 : 1 + ((r0 - M_CTX) >> 11), mb1 = (r1 - 1) < M_CTX ? 0 : 1 + ((r1 - 1 - M_CTX) >> 11);
            for (int i = tid; i < 4096; i += NWAVES * 64) { const int which = i >> 11, cidx = i & 2047, mb = which ? mb1 : mb0;
                float s = b_mod[cidx];
#pragma unroll
                for (int ks = 0; ks < 16; ++ks) s += MODP[((size_t)ks * 5 + mb) * 3072 + cidx];
                SS[i] = s; }
        }
        if (bx < 60 && tid < 256) {
            const int j = bx / 12, cidx = (bx % 12) * 256 + tid; float s = b_mod[cidx];
#pragma unroll
            for (int ks = 0; ks < 16; ++ks) s += MODP[((size_t)ks * 5 + j) * 3072 + cidx];
            MODF[j * 3072 + cidx] = s;
        }
        __syncthreads();
        if (r0 < MTOK) {
            const int mb0 = r0 < M_CTX ? 0 : 1 + ((r0 - M_CTX) >> 11);
            for (int m = r0 + wave; m < r1; m += NWAVES) {
                const float* xrow = m < M_CTX ? x_prompt + (size_t)m * DM : x_sample + (size_t)(m - M_CTX) * DM;
                const int mb = m < M_CTX ? 0 : 1 + ((m - M_CTX) >> 11);
                const LAS float* sp = SS + (mb == mb0 ? 0 : 2048);
                const f32x4* xr = (const f32x4*)xrow + lane;
                f32x4 v[4]; float s = 0.f;
#pragma unroll
                for (int j = 0; j < 4; ++j) { v[j] = xr[64 * j]; s += (v[j].x + v[j].y) + (v[j].z + v[j].w); }
                const float mean = wave_sum(s) * (1.f / DM); float s2 = 0.f;
#pragma unroll
                for (int j = 0; j < 4; ++j) { v[j] = v[j] - mean; s2 += (v[j].x * v[j].x + v[j].y * v[j].y) + (v[j].z * v[j].z + v[j].w * v[j].w); }
                const float rstd = 1.f / sqrtf(wave_sum(s2) * (1.f / DM) + MOD_EPS);
                unsigned* o4 = (unsigned*)(H8 + (size_t)m * DM) + lane;
                u32x2* o8 = (u32x2*)(HCTX + (size_t)m * DM) + lane;
#pragma unroll
                for (int j = 0; j < 4; ++j) { const int cidx = 256 * j + 4 * lane;
                    const f32x4 sh = *(const LAS f32x4*)(sp + cidx), sc = *(const LAS f32x4*)(sp + 1024 + cidx);
                    const f32x4 hv = v[j] * rstd * (sc + 1.f) + sh;
                    o4[64 * j] = cvt4_fp8(hv[0], hv[1], hv[2], hv[3]);
                    if (m < M_CTX) { u32x2 w; w.x = cvt_pk_bf16(hv[0], hv[1]); w.y = cvt_pk_bf16(hv[2], hv[3]); o8[64 * j] = w; } }
            }
        }
        __syncthreads();
    }
    SEAM(1);

    if (IN(2)) {
        pg8::EpiProj E{QA, ZA, QR, KR, VR, ZR, GT, KC, VC, KL, VL, dout + OUT_K, dout + OUT_V, ROPE, b_gate};
        { pg8::Gemm g{HCTX, WKV, HCTX, WKV, 2048, 128, 2048, 128, 16, 0, 0}; pg8::KvOrder S{G, bx, REP_P1};
          pg8::gemm_phase<pg8::EpiProj, pg8::KvOrder, true, true, false>(ldsl, g, S, E); }
        { pg8::Gemm g{H8, W8CAT, H8, W8CAT, 1024, 128, 1024, 128, 8, 0x7a7a7a7a, 0x7f7f7f7f}; pg8::ProjOrder8 S{G, bx, REP_P1};
          pg8::gemm_phase<pg8::EpiProj, pg8::ProjOrder8, true, true, true>(ldsl, g, S, E); }
    }
    SEAM(2);

    if (IN(3)) {
        const float lam = MISCW[0];
        constexpr int N_LAT_U = LAT_B * NH * (LAT_N / 128), N_CTX_U = CTX_B * NH * (CTX_N / 128), N_R1 = NCHUNK * NH;
        REPEAT(REP_P2A) for (int it = vcu; it < N_LAT_U + N_CTX_U; it += G) {
            size_t qoff, koff; const bf16_t* Kb; const bf16_t* Vb; int seq;
            if (it < N_LAT_U) {
                const int bh = it >> 4, qb = it & 15, b = bh >> 3, h = bh & 7;
                qoff = ((size_t)(M_CTX + b * LAT_N + qb * 128)) * 1024 + h * 128; koff = (size_t)b * LAT_KEYS * 1024 + h * 128; Kb = KL; Vb = VL; seq = LAT_KEYS;
            } else {
                const int u = it - N_LAT_U, bh = u >> 1, qb = u & 1, b = bh >> 3, h = bh & 7;
                qoff = ((size_t)(b * CTX_N + qb * 128)) * 1024 + h * 128; koff = (size_t)b * CTX_N * 1024 + h * 128; Kb = KC; Vb = VC; seq = CTX_N;
            }
            att::attn_unit(QA + qoff, Kb + koff, Vb + koff, seq, lam, subln_g, ZA + qoff, (rep_ + 1 < REP_P2A) ? (ws + WS_END) : (unsigned char*)(QA + qoff), (char*)lds);
        }
        REPEAT(REP_P2B) for (int u = vcu; u < N_R1; u += G) {
            const int gc = u >> 3, h = u & 7;
            att::ret_local_unit(KR + (size_t)gc * 128 * 512 + h * 64, VR + (size_t)gc * 128 * 1024 + h * 128, log2_gamma(ret_decay[h]), log2_gamma(ret_decay[8 + h]), LST + (size_t)u * 16384, (char*)lds);
        }
    }
    SEAM(3);

    if (IN(4)) REPEAT(REP_P3) {
        for (int idx = gt; idx < 160 * 4096; idx += NGT) {
            const int chain = idx >> 12, rem = idx & 4095, dir = rem >> 11, e = (rem & 2047) * 4;
            int b, h, nc, gc0; f32x4 S;
            if (chain < 128) { b = chain >> 3; h = chain & 7; nc = 2; gc0 = b * 2; S = (f32x4){0.f, 0.f, 0.f, 0.f}; }
            else { const int cb = chain - 128; b = cb >> 3; h = cb & 7; nc = 16; gc0 = 32 + b * 16; S = *(const f32x4*)((dir ? st_b : st_f) + (size_t)(b * 8 + h) * 8192 + e); }
            const float dec = exp2f(log2_gamma(ret_decay[dir * 8 + h]) * 128.f);
            for (int cc = 0; cc < nc; ++cc) {
                const int c = dir ? nc - 1 - cc : cc; const size_t u = (size_t)(gc0 + c) * 8 + h;
                u32x2 w; w.x = cvt_pk_bf16(S[0], S[1]); w.y = cvt_pk_bf16(S[2], S[3]);
                *(u32x2*)(PST + (u * 2 + dir) * 8192 + e) = w;
                S = S * dec + *(const f32x4*)(LST + u * 16384 + dir * 8192 + e);
            }
            if (chain < 128) *(f32x4*)(dout + (dir ? OUT_SB : OUT_SF) + (size_t)(b * 8 + h) * 8192 + e) = S;
        }
    }
    SEAM(4);

    if (IN(5)) REPEAT(REP_P4) {
        for (int u = vcu; u < NCHUNK * NH; u += G) {
            const int gc = u >> 3, h = u & 7; const size_t t0 = (size_t)gc * 128;
            att::ret_out_unit(QR + t0 * 512 + h * 64, KR + t0 * 512 + h * 64, VR + t0 * 1024 + h * 128, PST + ((size_t)u * 2) * 8192, PST + ((size_t)u * 2 + 1) * 8192,
                              log2_gamma(ret_decay[h]), log2_gamma(ret_decay[8 + h]), ret_gn_g + h * 128, ZR + t0 * 1024 + h * 128, (rep_ + 1 < REP_P4) ? (ws + WS_END) : (unsigned char*)(VR + t0 * 1024 + h * 128), (char*)lds);
        }
    }
    SEAM(5);

    if (IN(6)) {
        pg8::Gemm g{QA, W8PA, VR, W8PR, 2048, 256, 1024, 128, 8, 0x79797979, 0x7d7d7d7d}; pg8::PanelOrder<true> S{bx, REP_P5};
        pg8::EpiMerge E{GT, M8, 8.f};
        pg8::gemm_phase<pg8::EpiMerge, pg8::PanelOrder<true>, true, true, true>(ldsl, g, S, E);
    }
    SEAM(6);

    if (IN(7)) {
        pg8::Gemm g{M8, W8OUT, M8, W8OUT, 1024, 128, 1024, 128, 8, 0x79797979, 0x7c7c7c7c}; pg8::PanelOrder<false> S{bx, 1};
        pg8::EpiOut E{x_prompt, x_sample, MODF, dout + OUT_Y, STATS};
        pg8::gemm_phase<pg8::EpiOut, pg8::PanelOrder<false>, false, true, true>(ldsl, g, S, E);
    }
    SEAM(7);

    if (IN(8)) REPEAT(REP_P7) {
        for (int m = gw; m < MTOK; m += NGW) {
            const f32x4 s0 = *(const f32x4*)(STATS + (size_t)m * 8), s1 = *(const f32x4*)(STATS + (size_t)m * 8 + 4);
            const float mean = (s0[0] + s0[2] + s1[0] + s1[2]) * 0.25f;
            const float d0 = s0[0] - mean, d1 = s0[2] - mean, d2 = s1[0] - mean, d3 = s1[2] - mean;
            const float m2 = (s0[1] + s0[3]) + (s1[1] + s1[3]) + 256.f * ((d0 * d0 + d1 * d1) + (d2 * d2 + d3 * d3));
            const float rstd = 1.f / sqrtf(m2 * (1.f / DM) + LN_EPS);
            f32x4* yr = (f32x4*)(dout + OUT_Y + (size_t)m * DM) + lane;
            f32x4* yw = (rep_ + 1 < REP_P7) ? (f32x4*)(ws + WS_END) + lane : yr;
#pragma unroll
            for (int j = 0; j < 4; ++j) { const int cidx = 256 * j + 4 * lane; const f32x4 v = yr[64 * j];
                yw[64 * j] = (v - mean) * rstd * *(const f32x4*)(ln_g + cidx) + *(const f32x4*)(ln_b + cidx); }
        }
    }
#undef IN
#undef SEAM
}

extern "C" void kernel_launch(void* const* d_in, const int* in_sizes, int n_in, void* d_out, int out_size, void* d_ws, size_t ws_size, hipStream_t stream) {
    static int grid = 0;
    if (grid == 0) {
        if (n_in != 22 || out_size != (int)OUT_END || ws_size < WS_END) { fprintf(stderr, "kernel_launch: unexpected shapes: n_in %d out %d ws %zu (need >= %zu); nothing launched\n", n_in, out_size, ws_size, (size_t)WS_END); grid = -1; return; }
        int dev = 0, cus = 0, per_cu = 0;
        if (hipGetDevice(&dev) != hipSuccess || hipDeviceGetAttribute(&cus, hipDeviceAttributeMultiprocessorCount, dev) != hipSuccess) { fprintf(stderr, "kernel_launch: device query failed\n"); grid = -1; return; }
        if (hipFuncSetAttribute((const void*)mk_fwd, hipFuncAttributeMaxDynamicSharedMemorySize, LDS_BYTES) != hipSuccess) { fprintf(stderr, "kernel_launch: hipFuncSetAttribute failed\n"); grid = -1; return; }
        if (hipOccupancyMaxActiveBlocksPerMultiprocessor(&per_cu, (const void*)mk_fwd, NWAVES * 64, LDS_BYTES) != hipSuccess || per_cu < 1) {
            fprintf(stderr, "kernel_launch: occupancy query reports %d workgroups per CU\n", per_cu); }
        (void)hipGetLastError();
        grid = cus;
        if (grid != 256) fprintf(stderr, "kernel_launch: %d CUs; the panel phases expect 256\n", grid);
    }
    if (grid < 0) return;
    (void)hipMemsetAsync((char*)d_ws + WS_CTL, 0, CTL_ZERO_BYTES, stream);
    Args a{};
    for (int i = 0; i < 22; ++i) a.in[i] = (const float*)d_in[i];
    a.out = (float*)d_out; a.ws = (unsigned char*)d_ws;
#if MK_N_LAUNCHES == 1
    a.ph_lo = 0; a.ph_hi = N_PHASES;
    hipLaunchKernelGGL(mk_fwd, dim3(grid), dim3(NWAVES * 64), LDS_BYTES, stream, a);
#else
    for (int p = 0; p < N_PHASES; ++p) { a.ph_lo = p; a.ph_hi = p + 1; hipLaunchKernelGGL(mk_fwd, dim3(grid), dim3(NWAVES * 64), LDS_BYTES, stream, a); }
#endif
    const hipError_t le = hipPeekAtLastError();
    if (le != hipSuccess) fprintf(stderr, "kernel_launch: launch failed: %s\n", hipGetErrorName(le));
}
```
